# Optimizing an MI355X kernel written in HIP

```python
import math
import jax, jax.numpy as jnp
from jax import lax
import numpy as np

D_MODEL = 2048
BATCH = 4
SEQ = 4096
DEPTH = 4

CONV_DIM = 512
CONV_WIDTH = 3
SWA_HEADS = 8
SWA_KV_HEADS = 2
SWA_GROUP = SWA_HEADS // SWA_KV_HEADS
SWA_HEAD_DIM = 64
SWA_WINDOW = 128
SWA_BLOCK = 128
MLA_HEADS = 4
MLA_Q_RANK = 512
MLA_KV_RANK = 256
MLA_NOPE_DIM = 128
MLA_ROPE_DIM = 64
MLA_V_DIM = 128
MLA_QK_DIM = MLA_NOPE_DIM + MLA_ROPE_DIM
MLA_BLOCK = 128
ROPE_THETA = 10000.0
POOL_WINDOWS = (2, 4, 8, 16)
POOL_GROUPS = 4
POOL_GROUP_DIM = 128
POOL_DIM = POOL_GROUPS * POOL_GROUP_DIM
N_BRANCHES = 4
BRANCH_DIM = 512
IN_SIZES = (CONV_DIM, CONV_DIM, CONV_DIM,
            SWA_HEADS * SWA_HEAD_DIM, SWA_KV_HEADS * SWA_HEAD_DIM, SWA_KV_HEADS * SWA_HEAD_DIM,
            MLA_Q_RANK, MLA_KV_RANK, MLA_ROPE_DIM,
            POOL_DIM,
            N_BRANCHES * D_MODEL)
IN_DIM = sum(IN_SIZES)
PEER_HEADS = 8
PEER_N_KEYS = 128
PEER_N_EXPERTS = PEER_N_KEYS * PEER_N_KEYS
PEER_KEY_DIM = 128
PEER_TOPK = 16
PEER_CHUNK = 128
DN_ALPHA = (2 * DEPTH) ** 0.25
DN_BETA = (8 * DEPTH) ** -0.25
NORM_EPS = 1e-5
NEG_INF = -1e30

kernel_name = "hybrid_gated_conv_swa_mla_pool_peer_deepnorm"


def _layer_norm(x, g, b):
    x32 = x.astype(jnp.float32)
    mu = jnp.mean(x32, axis=-1, keepdims=True)
    var = jnp.mean(jnp.square(x32 - mu), axis=-1, keepdims=True)
    return ((x32 - mu) * lax.rsqrt(var + NORM_EPS)).astype(x.dtype) * g + b


def _rms_norm(x, g):
    x32 = x.astype(jnp.float32)
    return (x32 * lax.rsqrt(jnp.mean(x32 * x32, axis=-1, keepdims=True) + NORM_EPS)).astype(x.dtype) * g


def _split_columns(h):
    offsets = np.cumsum(np.array(IN_SIZES))[:-1].tolist()
    return jnp.split(h, offsets, axis=-1)


def _alibi_slopes(n):
    return jnp.asarray(2.0 ** (-8.0 * np.arange(1, n + 1) / n), dtype=jnp.float32)


def _rope(x, cos, sin):
    x1, x2 = jnp.split(x, 2, axis=-1)
    c = cos[:, None, :]
    s = sin[:, None, :]
    return jnp.concatenate([x1 * c - x2 * s, x2 * c + x1 * s], axis=-1)


def _short_conv(u, gate_b, gate_c, conv_w):
    z = gate_c * u
    y = lax.conv_general_dilated(z, conv_w[:, None, :].astype(z.dtype), window_strides=(1,),
                                 padding=[(CONV_WIDTH - 1, 0)],
                                 dimension_numbers=('NWC', 'WIO', 'NWC'),
                                 feature_group_count=CONV_DIM)
    return gate_b * y


def _sliding_window_attention(q, k, v, sinks):
    b, s, _ = q.shape
    nb = s // SWA_BLOCK
    qb = q.reshape(b, nb, SWA_BLOCK, SWA_KV_HEADS, SWA_GROUP, SWA_HEAD_DIM)
    kb = k.reshape(b, nb, SWA_BLOCK, SWA_KV_HEADS, SWA_HEAD_DIM)
    vb = v.reshape(b, nb, SWA_BLOCK, SWA_KV_HEADS, SWA_HEAD_DIM)
    pad = ((0, 0), (1, 0), (0, 0), (0, 0), (0, 0))
    k_band = jnp.concatenate([jnp.pad(kb, pad)[:, :-1], kb], axis=2)
    v_band = jnp.concatenate([jnp.pad(vb, pad)[:, :-1], vb], axis=2)
    sc = jnp.einsum('bnqkgd,bnskd->bnkgqs', qb, k_band).astype(jnp.float32) * (SWA_HEAD_DIM ** -0.5)
    i = jnp.arange(SWA_BLOCK)[:, None]
    j = jnp.arange(2 * SWA_BLOCK)[None, :]
    dist = i - j + SWA_BLOCK
    key_pos = jnp.arange(nb)[:, None] * SWA_BLOCK - SWA_BLOCK + jnp.arange(2 * SWA_BLOCK)[None, :]
    mask = ((dist >= 0) & (dist < SWA_WINDOW))[None] & (key_pos >= 0)[:, None, :]
    slopes = _alibi_slopes(SWA_HEADS).reshape(SWA_KV_HEADS, SWA_GROUP)
    sc = sc - slopes[:, :, None, None] * dist.astype(jnp.float32)
    sc = jnp.where(mask[None, :, None, None], sc, NEG_INF)
    sink = jnp.broadcast_to(sinks.astype(jnp.float32).reshape(1, 1, SWA_KV_HEADS, SWA_GROUP, 1, 1),
                            sc.shape[:-1] + (1,))
    probs = jax.nn.softmax(jnp.concatenate([sc, sink], axis=-1), axis=-1)[..., :-1]
    o = jnp.einsum('bnkgqs,bnskd->bnqkgd', probs.astype(v.dtype), v_band)
    return o.reshape(b, s, SWA_HEADS * SWA_HEAD_DIM)


def _latent_attention(c_q, c_kv, k_rope_in, q_norm, w_q_up, kv_norm, w_kv_up, cos, sin):
    b, s, _ = c_q.shape
    q = (_rms_norm(c_q, q_norm) @ w_q_up).reshape(b, s, MLA_HEADS, MLA_QK_DIM)
    q = jnp.concatenate([q[..., :MLA_NOPE_DIM], _rope(q[..., MLA_NOPE_DIM:], cos, sin)], axis=-1)
    kv = (_rms_norm(c_kv, kv_norm) @ w_kv_up).reshape(b, s, MLA_HEADS, MLA_NOPE_DIM + MLA_V_DIM)
    k_pe = _rope(k_rope_in[:, :, None, :], cos, sin)
    k = jnp.concatenate([kv[..., :MLA_NOPE_DIM],
                         jnp.broadcast_to(k_pe, (b, s, MLA_HEADS, MLA_ROPE_DIM))], axis=-1)
    v = kv[..., MLA_NOPE_DIM:]
    nb = s // MLA_BLOCK
    qb = q.reshape(b, nb, MLA_BLOCK, MLA_HEADS, MLA_QK_DIM).transpose(1, 0, 2, 3, 4)
    key_idx = jnp.arange(s)

    def block(args):
        q_blk, n = args
        sc = jnp.einsum('bqhd,bshd->bhqs', q_blk, k).astype(jnp.float32) * (MLA_QK_DIM ** -0.5)
        t = n * MLA_BLOCK + jnp.arange(MLA_BLOCK)
        sc = jnp.where(key_idx[None, :] <= t[:, None], sc, NEG_INF)
        p = jax.nn.softmax(sc, axis=-1).astype(v.dtype)
        return jnp.einsum('bhqs,bshd->bqhd', p, v)

    o = lax.map(block, (qb, jnp.arange(nb)))
    return o.transpose(1, 0, 2, 3, 4).reshape(b, s, MLA_HEADS * MLA_V_DIM)


def _multiscale_pool(u, pool_w, pool_scale):
    b, s, _ = u.shape
    u32 = u.astype(jnp.float32)
    cs0 = jnp.pad(jnp.cumsum(u32, axis=1), ((0, 0), (1, 0), (0, 0)))
    cur = cs0[:, 1:]
    pos1 = jnp.arange(s) + 1
    groups = []
    for g, w in enumerate(POOL_WINDOWS):
        sl = slice(g * POOL_GROUP_DIM, (g + 1) * POOL_GROUP_DIM)
        prev = jnp.pad(cs0[:, :, sl], ((0, 0), (w - 1, 0), (0, 0)))[:, :s]
        count = jnp.minimum(pos1, w).astype(jnp.float32)[None, :, None]
        groups.append((cur[:, :, sl] - prev) / count - u32[:, :, sl])
    y = jnp.stack(groups, axis=2).astype(u.dtype)
    y = jnp.einsum('bsgc,gcd->bsgd', y, pool_w).reshape(b, s, POOL_DIM)
    return y * pool_scale


def _token_mixer(x, w_in, conv_w, swa_sinks, mla_q_norm, mla_w_q_up, mla_kv_norm, mla_w_kv_up,
                 pool_w, pool_scale, w_branch, w_out, cos, sin):
    b, s, d = x.shape
    (conv_u, conv_b, conv_c, swa_q, swa_k, swa_v, mla_cq, mla_ckv, mla_kr,
     pool_u, gate_pre) = _split_columns(x @ w_in)
    branches = (
        _short_conv(conv_u, conv_b, conv_c, conv_w),
        _sliding_window_attention(swa_q, swa_k, swa_v, swa_sinks),
        _latent_attention(mla_cq, mla_ckv, mla_kr, mla_q_norm, mla_w_q_up, mla_kv_norm, mla_w_kv_up, cos, sin),
        _multiscale_pool(pool_u, pool_w, pool_scale),
    )
    gates = jax.nn.sigmoid(gate_pre).reshape(b, s, N_BRANCHES, d)
    merged = gates[:, :, 0] * (branches[0] @ w_branch[0])
    for i in range(1, N_BRANCHES):
        merged = merged + gates[:, :, i] * (branches[i] @ w_branch[i])
    return merged @ w_out


def _peer(x, w_query, sub_keys, u_table, v_table):
    b, s, d = x.shape
    xt = x.reshape(-1, d)
    t = xt.shape[0]
    q = (xt @ w_query).reshape(t, PEER_HEADS, 2, PEER_KEY_DIM)
    sc = jnp.einsum('thpk,pnk->thpn', q, sub_keys).astype(jnp.float32)
    top_s, top_i = lax.top_k(sc, PEER_TOPK)
    cand = (top_s[:, :, 0, :, None] + top_s[:, :, 1, None, :]).reshape(t, PEER_HEADS, PEER_TOPK * PEER_TOPK)
    best_s, best_j = lax.top_k(cand, PEER_TOPK)
    i1 = jnp.take_along_axis(top_i[:, :, 0], best_j // PEER_TOPK, axis=-1)
    i2 = jnp.take_along_axis(top_i[:, :, 1], best_j % PEER_TOPK, axis=-1)
    expert = i1 * PEER_N_KEYS + i2
    g = jax.nn.softmax(best_s, axis=-1).astype(x.dtype)
    nc = t // PEER_CHUNK
    hk = PEER_HEADS * PEER_TOPK

    def chunk(args):
        xc, idx, gc = args
        u = jnp.take(u_table, idx, axis=0)
        a = jnp.einsum('cd,ckd->ck', xc, u)
        coef = gc * jax.nn.gelu(a, approximate=False)
        vv = jnp.take(v_table, idx, axis=0)
        return jnp.einsum('ck,ckd->cd', coef, vv)

    out = lax.map(chunk, (xt.reshape(nc, PEER_CHUNK, d), expert.reshape(nc, PEER_CHUNK, hk),
                          g.reshape(nc, PEER_CHUNK, hk)))
    return out.reshape(b, s, d)


def setup_inputs(seed: int = 0) -> dict:
    key = jax.random.key(seed)
    ks = jax.random.split(key, 20)
    L, D = DEPTH, D_MODEL

    def nrm(k, shape, scale):
        return jax.random.normal(k, shape, jnp.float32) * scale

    return {
        "x": nrm(ks[0], (BATCH, SEQ, D), 1.0),
        "w_in": nrm(ks[1], (L, D, IN_DIM), D ** -0.5),
        "conv_w": nrm(ks[2], (L, CONV_WIDTH, CONV_DIM), CONV_WIDTH ** -0.5),
        "swa_sinks": nrm(ks[3], (L, SWA_HEADS), 0.5),
        "mla_q_norm": 1.0 + nrm(ks[4], (L, MLA_Q_RANK), 0.02),
        "mla_w_q_up": nrm(ks[5], (L, MLA_Q_RANK, MLA_HEADS * MLA_QK_DIM), MLA_Q_RANK ** -0.5),
        "mla_kv_norm": 1.0 + nrm(ks[6], (L, MLA_KV_RANK), 0.02),
        "mla_w_kv_up": nrm(ks[7], (L, MLA_KV_RANK, MLA_HEADS * (MLA_NOPE_DIM + MLA_V_DIM)), MLA_KV_RANK ** -0.5),
        "pool_w": nrm(ks[8], (L, POOL_GROUPS, POOL_GROUP_DIM, POOL_GROUP_DIM), POOL_GROUP_DIM ** -0.5),
        "pool_scale": 1.0 + nrm(ks[9], (L, POOL_DIM), 0.02),
        "w_branch": nrm(ks[10], (L, N_BRANCHES, BRANCH_DIM, D), DN_BETA * BRANCH_DIM ** -0.5),
        "w_out": nrm(ks[11], (L, D, D), DN_BETA * D ** -0.5),
        "ln1_g": 1.0 + nrm(ks[12], (L, D), 0.02),
        "ln1_b": nrm(ks[13], (L, D), 0.02),
        "peer_w_query": nrm(ks[14], (L, D, PEER_HEADS * 2 * PEER_KEY_DIM), D ** -0.5),
        "peer_sub_keys": nrm(ks[15], (L, 2, PEER_N_KEYS, PEER_KEY_DIM), PEER_KEY_DIM ** -0.5),
        "peer_u": nrm(ks[16], (L, PEER_N_EXPERTS, D), D ** -0.5),
        "peer_v": nrm(ks[17], (L, PEER_N_EXPERTS, D), DN_BETA * (PEER_HEADS * PEER_TOPK) ** -0.5),
        "ln2_g": 1.0 + nrm(ks[18], (L, D), 0.02),
        "ln2_b": nrm(ks[19], (L, D), 0.02),
    }


def reference(x, w_in, conv_w, swa_sinks, mla_q_norm, mla_w_q_up, mla_kv_norm, mla_w_kv_up,
              pool_w, pool_scale, w_branch, w_out, ln1_g, ln1_b, peer_w_query, peer_sub_keys,
              peer_u, peer_v, ln2_g, ln2_b):
    s = x.shape[1]
    pos = jnp.arange(s, dtype=jnp.float32)
    inv_freq = ROPE_THETA ** (-jnp.arange(0, MLA_ROPE_DIM, 2, dtype=jnp.float32) / MLA_ROPE_DIM)
    ang = pos[:, None] * inv_freq[None, :]
    cos = jnp.cos(ang).astype(x.dtype)
    sin = jnp.sin(ang).astype(x.dtype)
    for l in range(DEPTH):
        mix = _token_mixer(x, w_in[l], conv_w[l], swa_sinks[l], mla_q_norm[l], mla_w_q_up[l],
                           mla_kv_norm[l], mla_w_kv_up[l], pool_w[l], pool_scale[l], w_branch[l],
                           w_out[l], cos, sin)
        h = _layer_norm(DN_ALPHA * x + mix, ln1_g[l], ln1_b[l])
        ffn = _peer(h, peer_w_query[l], peer_sub_keys[l], peer_u[l], peer_v[l])
        x = _layer_norm(DN_ALPHA * h + ffn, ln2_g[l], ln2_b[l])
    return x
```

```cpp
#define MK_PER_PHASE 0
#define PEER_PIN 1
#include <hip/hip_runtime.h>
#include <cstdio>
#include <cstdint>
#include <cmath>

#ifndef MK_PER_PHASE
#define MK_PER_PHASE 0
#endif

#define DI __device__ __forceinline__
#define LAS __attribute__((address_space(3)))
#define GAS __attribute__((address_space(1)))
typedef unsigned short bf16;
typedef short bf16x8 __attribute__((ext_vector_type(8)));
typedef short s16x4 __attribute__((ext_vector_type(4)));
typedef float f32x4 __attribute__((ext_vector_type(4)));
typedef float f32x2 __attribute__((ext_vector_type(2)));
typedef float f32x16 __attribute__((ext_vector_type(16)));
typedef float f32x32 __attribute__((ext_vector_type(32)));
typedef unsigned u32x6 __attribute__((ext_vector_type(6)));
typedef unsigned u32x16 __attribute__((ext_vector_type(16)));
typedef unsigned u32x4 __attribute__((ext_vector_type(4)));
typedef unsigned u32x2 __attribute__((ext_vector_type(2)));
typedef __bf16 bf16x2_t __attribute__((ext_vector_type(2)));
typedef __bf16 bf16x8_t __attribute__((ext_vector_type(8)));

constexpr int D = 2048, BATCH = 4, SEQ = 4096, T = BATCH * SEQ, DEPTH = 4;
constexpr int NGATE = 4 * D;
constexpr int NHM = 3648, HM_LD = 3840;
constexpr int N1 = NGATE + HM_LD;
constexpr int IN_DIM = 11840;
constexpr int C_CONVU = 0, C_CONVB = 512, C_CONVC = 1024, C_SWAQ = 1536, C_SWAK = 2048, C_SWAV = 2176, C_CQ = 2304, C_CKV = 2816, C_KR = 3072, C_POOL = 3136;
constexpr float DN_ALPHA = 1.681792830507429f;
constexpr float NORM_EPS = 1e-5f;
constexpr float LOG2E = 1.4426950408889634f;
constexpr int NEXP = 16384;

constexpr size_t MiB = 1u << 20;
constexpr size_t WS_CTL = 0, CTL_ZERO_BYTES = 1 * MiB;
constexpr size_t WS_WIN = 1 * MiB;
constexpr size_t SZ_WIN = (size_t)N1 * D * 2;
constexpr size_t WS_WQUP = WS_WIN + 4 * SZ_WIN;
constexpr size_t SZ_WQUP = 768 * 512 * 2;
constexpr size_t WS_WKVUP = WS_WQUP + 4 * SZ_WQUP;
constexpr size_t SZ_WKVUP = 1024 * 256 * 2;
constexpr size_t WS_WPOOL = WS_WKVUP + 4 * SZ_WKVUP;
constexpr size_t SZ_WPOOL = 512 * 512 * 2;
constexpr size_t WS_WBR = WS_WPOOL + 4 * SZ_WPOOL;
constexpr size_t SZ_WBR = (size_t)4 * D * 512 * 2;
constexpr size_t WS_WOUT = WS_WBR + 4 * SZ_WBR;
constexpr size_t SZ_WSQ = (size_t)D * D * 2;
constexpr size_t WS_WPQ = WS_WOUT + 4 * SZ_WSQ;
constexpr size_t WS_TABU = WS_WPQ + 4 * SZ_WSQ;
constexpr int ROWB = 1536;
constexpr size_t SZ_TAB = (size_t)NEXP * ROWB;
constexpr float U_SCALE = 80.f, V_SCALE = 48.f;
#ifndef FP6_INTERLEAVED
#define FP6_INTERLEAVED 1
#endif
DI constexpr int fp6_map(int j) { return FP6_INTERLEAVED ? (j >> 1) + 16 * (j & 1) : j; }
constexpr size_t WS_TABV = WS_TABU + 4 * SZ_TAB;
constexpr size_t WS_ROPE = WS_TABV + 4 * SZ_TAB;
constexpr size_t WS_XA = WS_ROPE + 1 * MiB;
constexpr size_t WS_XB = WS_XA + (size_t)T * D * 4;
constexpr size_t WS_R1 = WS_XB + (size_t)T * D * 2;
constexpr size_t WS_HM = WS_R1 + (size_t)T * NGATE * 2;
constexpr size_t WS_BR = WS_HM + (size_t)T * HM_LD * 2;
constexpr size_t WS_PY = WS_BR + (size_t)T * D * 2;
constexpr size_t WS_KPE = WS_PY + (size_t)T * 512 * 2;
constexpr size_t WS_RS = WS_KPE + (size_t)T * 64 * 2;
constexpr size_t WS_Q = WS_RS + 1 * MiB;
constexpr size_t WS_KN = WS_Q + (size_t)T * 768 * 2;
constexpr size_t WS_VT = WS_KN + (size_t)T * 512 * 2;
constexpr size_t WS_SLAB = WS_VT + (size_t)T * 512 * 2;
constexpr size_t WS_ST = WS_SLAB;
constexpr size_t WS_MG = WS_SLAB + (size_t)256 * 65536 * 4;
constexpr size_t WS_HB = WS_MG + (size_t)T * D * 2;
constexpr size_t WS_END = WS_HB + (size_t)T * D * 2;
static_assert(WS_END <= (size_t)2047 * MiB, "workspace map");

constexpr int CW_TMO = 0;
constexpr int CW_BAR = 4096;
constexpr int CW_CS = 65536, CW_BW = CW_CS + 4 * 2048;

constexpr int RING_BYTES = 131072;
constexpr int LDSCTL_OFF = RING_BYTES, MISC_OFF = LDSCTL_OFF + 320;
constexpr int LDS_BYTES = 147456;
constexpr int NWAVES = 8;

DI unsigned pk2(float lo, float hi) { f32x2 v = {lo, hi}; bf16x2_t b = __builtin_convertvector(v, bf16x2_t); return __builtin_bit_cast(unsigned, b); }
DI float bflo(unsigned u) { return __uint_as_float(u << 16); }
DI float bfhi(unsigned u) { return __uint_as_float(u & 0xffff0000u); }
DI float bf2f(bf16 b) { return __uint_as_float(((unsigned)b) << 16); }
DI bf16 f2bf(float f) { return (bf16)(pk2(f, 0.f) & 0xffffu); }
DI float wave_sum(float v) {
#pragma unroll
    for (int o = 1; o < 64; o <<= 1) v += __shfl_xor(v, o);
    return v;
}
DI float fast_exp2(float x) { return __builtin_amdgcn_exp2f(x); }
DI float fast_rcp(float x) { return __builtin_amdgcn_rcpf(x); }
#define LDS_WAIT() asm volatile("s_waitcnt lgkmcnt(0)" ::: "memory")
#define VM_WAIT() asm volatile("s_waitcnt vmcnt(0)" ::: "memory")
#define MFMA32(a, b, c) __builtin_amdgcn_mfma_f32_32x32x16_bf16((a), (b), (c), 0, 0, 0)
DI int crow(int reg, int h) { return (reg & 3) + 8 * (reg >> 2) + 4 * h; }
DI f32x4 ld4bf_lo(u32x4 w) { return (f32x4){bflo(w.x), bfhi(w.x), bflo(w.y), bfhi(w.y)}; }
DI f32x4 ld4bf_hi(u32x4 w) { return (f32x4){bflo(w.z), bfhi(w.z), bflo(w.w), bfhi(w.w)}; }
DI int lane_id_opaque() { int l; asm volatile("v_mbcnt_lo_u32_b32 %0, -1, 0\n\tv_mbcnt_hi_u32_b32 %0, -1, %0" : "=&v"(l)); return l; }
DI f32x16 zero16() { float z = 0.f; asm volatile("" : "+v"(z)); f32x16 r; for (int i = 0; i < 16; ++i) r[i] = z; return r; }
DI bf16x2_t cvt2(float lo, float hi) { f32x2 v = {lo, hi}; return __builtin_convertvector(v, bf16x2_t); }
namespace pg8 {
constexpr int BM = 256, BK = 64, HALF = 128, HTB = HALF * BK * 2, STAGE_BYTES = 8 * HTB, NXCD = 8, WGM = 8;
__host__ __device__ __forceinline__ int lds_byte(int r, int c) { const int st = (r >> 4) * 2 + (c >> 5), rr = r & 15, cc = c & 31, ob = rr * 64 + cc * 2; return st * 1024 + (ob ^ (((ob >> 9) & 1) << 5)); }
__host__ __device__ __forceinline__ void stage_rc(int b, int& R, int& C) { const int st = b / 1024, sb = b % 1024, swz = sb ^ (((sb >> 9) & 1) << 5); R = (st >> 1) * 16 + swz / 64; C = (st & 1) * 32 + (swz % 64) / 2; }
__host__ __device__ __forceinline__ int perm32(int rho) { const int n = rho >> 4, i = rho & 15; return 8 * (i >> 2) + 4 * n + (i & 3); }

struct Unit { int pm, pn, aoff; };
struct Gemm { const GAS bf16* A; const GAS bf16* Bt; int K, lda, ldb; };

__device__ __forceinline__ void tile_of(int L, int nM, int nN, int& pm, int& pn) {
    const int nwg = nM * nN; int wgid = L;
    { const int q = nwg / NXCD, r = nwg % NXCD, xcd = wgid % NXCD, off = wgid / NXCD; wgid = (xcd < r ? xcd * (q + 1) : r * (q + 1) + (xcd - r) * q) + off; }
    const int nig = WGM * nN, gid = wgid / nig, fm = gid * WGM, gsz = (nM - fm) < WGM ? (nM - fm) : WGM;
    pm = fm + ((wgid % nig) % gsz); pn = (wgid % nig) / gsz;
}
struct StaticOrder {
    int nM, nN, nwg, G, c;
    __device__ __forceinline__ void init(int M, int N, int G_, int c_) { nM = M / BM; nN = N / BM; nwg = nM * nN; G = G_; c = c_; }
    __device__ __forceinline__ bool next(int i, Unit& u) const {
        const long L = (long)i * G + c; if (L >= nwg) return false;
        tile_of((int)L, nM, nN, u.pm, u.pn); u.aoff = 0; return true;
    }
};
struct MergeOrder {
    int G, c;
    __device__ __forceinline__ bool next(int i, Unit& u) const {
        const long L = (long)(i >> 2) * G + c; if (L >= 512) return false;
        int pm, pn; tile_of((int)L, 64, 8, pm, pn); const int br = i & 3;
        u.pm = pm; u.pn = br * 8 + pn; u.aoff = br * 1024; return true;
    }
};

template <class Epi, class Sched>
__device__ __forceinline__ void gemm_phase(LAS unsigned char* lds, int wave_s, const Gemm g, const Sched& S, const Epi& E) {
    asm volatile("" : "+s"(wave_s));
    const int lane = lane_id_opaque(), wid = wave_s, tid = wid * 64 + lane, wr = wid >> 2, wc = wid & 3, fr = lane & 15, fq = lane >> 4;
    const int K = g.K, nt = K / BK;
    unsigned voffA[2], voffB[2];
#pragma unroll
    for (int i = 0; i < 2; ++i) { int R, C; stage_rc(tid * 16 + i * 8192, R, C); const int Rb = Epi::PERM ? ((R & ~31) + perm32(R & 31)) : R;
        voffA[i] = (unsigned)(R * g.lda + C) * 2u; voffB[i] = (unsigned)(Rb * g.ldb + C) * 2u; }
    const size_t kstep = (size_t)(BK * 2);
    const size_t hstepA = (size_t)HALF * g.lda * 2, hstepB = (size_t)HALF * g.ldb * 2;
    const size_t tstepA = 2 * hstepA, tstepB = 2 * hstepB;
    const unsigned ldsw = (unsigned)wid * 1024u;
    const int aoff = lds_byte(wr * 64 + fr, fq * 8), boff = lds_byte(wc * 32 + fr, fq * 8);
#define PG8_SA(b, h) (((b) * 2 + (h)) * HTB)
#define PG8_SB(b, h) ((4 + (b) * 2 + (h)) * HTB)
#define PG8_STAGE(bufoff, gbase, voff) do { _Pragma("unroll") for (int _i = 0; _i < 2; ++_i) \
        __builtin_amdgcn_global_load_lds((const GAS unsigned*)((const GAS char*)(gbase) + (voff)[_i]), (LAS unsigned*)(lds + (bufoff) + ldsw + _i * 8192), 16, 0, 0); } while (0)
#define PG8_LDA(dst, b, h) do { _Pragma("unroll") for (int m = 0; m < 4; ++m) _Pragma("unroll") for (int k = 0; k < 2; ++k) dst[m][k] = *(const LAS bf16x8*)(lds + PG8_SA(b, h) + aoff + m * 2048 + k * 1024); } while (0)
#define PG8_LDB(dst, b, h) do { _Pragma("unroll") for (int n = 0; n < 2; ++n) _Pragma("unroll") for (int k = 0; k < 2; ++k) dst[n][k] = *(const LAS bf16x8*)(lds + PG8_SB(b, h) + boff + n * 2048 + k * 1024); } while (0)
#define PG8_MMA(ai, bj, At, Bt) do { __builtin_amdgcn_s_setprio(1); _Pragma("unroll") for (int m = 0; m < 4; ++m) _Pragma("unroll") for (int n = 0; n < 2; ++n) _Pragma("unroll") for (int k = 0; k < 2; ++k) \
        acc[ai][bj][m][n] = __builtin_amdgcn_mfma_f32_16x16x32_bf16(Bt[n][k], At[m][k], acc[ai][bj][m][n], 0, 0, 0); __builtin_amdgcn_s_setprio(0); } while (0)
#define PG8_WAIT_V(n) asm volatile("s_waitcnt vmcnt(" #n ")" ::: "memory")
#define PG8_WAIT_L(n) asm volatile("s_waitcnt lgkmcnt(" #n ")" ::: "memory")
#define PG8_BAR __builtin_amdgcn_s_barrier()
#define PG8_SCHED __builtin_amdgcn_sched_barrier(0)
    Unit cur, nxt; int ui = 0;
    if (!S.next(0, cur)) return;
    f32x4 acc[2][2][4][2];
#pragma unroll
    for (int a = 0; a < 2; ++a)
#pragma unroll
        for (int b = 0; b < 2; ++b)
#pragma unroll
            for (int m = 0; m < 4; ++m)
#pragma unroll
                for (int n = 0; n < 2; ++n) acc[a][b][m][n] = (f32x4){0.f, 0.f, 0.f, 0.f};
    bf16x8 At[4][2], B0[2][2], B1[2][2];
    const GAS char* cA = (const GAS char*)g.A + (size_t)cur.pm * tstepA + cur.aoff; const GAS char* cB = (const GAS char*)g.Bt + (size_t)cur.pn * tstepB;
    PG8_STAGE(PG8_SB(0, 0), cB, voffB); PG8_STAGE(PG8_SB(0, 1), cB + hstepB, voffB); PG8_STAGE(PG8_SA(0, 0), cA, voffA); PG8_STAGE(PG8_SA(0, 1), cA + hstepA, voffA);
    if (wr == 1) PG8_BAR;
    PG8_WAIT_V(2); PG8_BAR;
    PG8_STAGE(PG8_SB(1, 0), cB + kstep, voffB); PG8_STAGE(PG8_SA(1, 0), cA + kstep, voffA); PG8_STAGE(PG8_SB(1, 1), cB + hstepB + kstep, voffB);
    PG8_WAIT_V(6); PG8_BAR;
    for (;;) {
        const bool has_next = S.next(ui + 1, nxt);
        const GAS char* nA = has_next ? (const GAS char*)g.A + (size_t)nxt.pm * tstepA + nxt.aoff : cA; const GAS char* nB = has_next ? (const GAS char*)g.Bt + (size_t)nxt.pn * tstepB : cB;
#pragma unroll 1
        for (int t = 0; t < nt; t += 2) {
            const bool last = (t == nt - 2);
            const GAS char* a1 = cA + (size_t)(t + 1) * kstep;
            const GAS char* a2 = last ? nA : cA + (size_t)(t + 2) * kstep; const GAS char* b2 = last ? nB : cB + (size_t)(t + 2) * kstep;
            const GAS char* a3 = a2 + kstep; const GAS char* b3 = b2 + kstep;
            PG8_LDB(B0, 0, 0); PG8_LDB(B1, 0, 1); PG8_SCHED; PG8_LDA(At, 0, 0); PG8_STAGE(PG8_SA(1, 1), a1 + hstepA, voffA);
            PG8_WAIT_V(8); PG8_WAIT_L(0); PG8_BAR; PG8_MMA(0, 0, At, B0); PG8_MMA(0, 1, At, B1); PG8_BAR; PG8_SCHED;
            PG8_LDA(At, 0, 1); PG8_STAGE(PG8_SB(0, 0), b2, voffB); PG8_STAGE(PG8_SB(0, 1), b2 + hstepB, voffB); PG8_STAGE(PG8_SA(0, 0), a2, voffA);
            PG8_WAIT_V(8); PG8_WAIT_L(0); PG8_BAR; PG8_MMA(1, 0, At, B0); PG8_MMA(1, 1, At, B1); PG8_BAR; PG8_SCHED;
            PG8_LDB(B0, 1, 0); PG8_LDB(B1, 1, 1); PG8_SCHED; PG8_LDA(At, 1, 0); PG8_STAGE(PG8_SA(0, 1), a2 + hstepA, voffA);
            PG8_WAIT_V(8); PG8_WAIT_L(0); PG8_BAR; PG8_MMA(0, 0, At, B0); PG8_MMA(0, 1, At, B1); PG8_BAR; PG8_SCHED;
            PG8_LDA(At, 1, 1); PG8_STAGE(PG8_SB(1, 0), b3, voffB); PG8_STAGE(PG8_SB(1, 1), b3 + hstepB, voffB); PG8_STAGE(PG8_SA(1, 0), a3, voffA);
            PG8_WAIT_V(8); PG8_WAIT_L(0); PG8_BAR; PG8_MMA(1, 0, At, B0); PG8_MMA(1, 1, At, B1); PG8_BAR; PG8_SCHED;
        }
        if (wr == 0) PG8_BAR;
        E(acc, cur, wr, wc, fr, fq);
        if (!has_next) break;
        if constexpr (!Epi::KEEP) {
#pragma unroll
        for (int a = 0; a < 2; ++a)
#pragma unroll
            for (int b = 0; b < 2; ++b)
#pragma unroll
                for (int m = 0; m < 4; ++m)
#pragma unroll
                    for (int n = 0; n < 2; ++n) acc[a][b][m][n] = (f32x4){0.f, 0.f, 0.f, 0.f};
        }
        cur = nxt; cA = nA; cB = nB; ++ui;
        if (wr == 1) PG8_BAR;
    }
    PG8_WAIT_V(0);
    PG8_BAR;
#undef PG8_SA
#undef PG8_SB
#undef PG8_STAGE
#undef PG8_LDA
#undef PG8_LDB
#undef PG8_MMA
#undef PG8_WAIT_V
#undef PG8_WAIT_L
#undef PG8_BAR
#undef PG8_SCHED
}

typedef f32x4 AccT[2][2][4][2];

struct EpiGemm1 {
    static constexpr bool PERM = true, KEEP = false;
    GAS bf16* gates; GAS bf16* hm;
    __device__ __forceinline__ void operator()(AccT& acc, const Unit& u, int wr, int wc, int fr, int fq) const {
        int ln; { ln = lane_id_opaque(); fr = ln & 15; fq = ln >> 4; }
        const int row0 = u.pm * BM + wr * 64 + fr; const bool isg = u.pn < 32;
        if (isg) {
            const int pnE = u.pn >> 2, bjE = (u.pn >> 1) & 1, wcE = 2 * (u.pn & 1) + (wc >> 1), fqE = 2 * (wc & 1) + (fq >> 1);
            GAS bf16* tb = gates + (size_t)((u.pm * 8 + pnE) * 4) * 65536 + (fr + 16 * fqE) * 8 + 4 * (fq & 1);
#pragma unroll
            for (int ai = 0; ai < 2; ++ai)
#pragma unroll
                for (int m = 0; m < 4; ++m) { GAS bf16* rowp = tb + ((((ai * 2 + wr) * 4 + m) * 2 + bjE) * 4 + wcE) * 512; float r[4][4];
#pragma unroll
                    for (int j = 0; j < 4; ++j) { float dn[4];
#pragma unroll
                        for (int i = 0; i < 4; ++i) dn[i] = fminf(1.f + fast_exp2(-LOG2E * acc[ai][i >> 1][m][i & 1][j]), 1e4f);
#pragma unroll
                        for (int i = 0; i < 4; ++i) r[i][j] = fast_rcp(dn[i]) * (i < 3 ? dn[(i + 1) & 3] : 1.0f); }
#pragma unroll
                    for (int i = 0; i < 4; ++i) *(GAS u32x2*)(rowp + i * 65536) = (u32x2){pk2(r[i][0], r[i][1]), pk2(r[i][2], r[i][3])}; }
        } else {
            const int col0 = (u.pn - 32) * BM + wc * 32 + 8 * fq;
#pragma unroll
            for (int ai = 0; ai < 2; ++ai)
#pragma unroll
                for (int m = 0; m < 4; ++m) { GAS bf16* rowp = hm + (size_t)(row0 + ai * HALF + m * 16) * HM_LD + col0;
#pragma unroll
                    for (int bj = 0; bj < 2; ++bj) { const f32x4 v0 = acc[ai][bj][m][0], v1 = acc[ai][bj][m][1];
                        u32x4 w; w.x = pk2(v0[0], v0[1]); w.y = pk2(v0[2], v0[3]); w.z = pk2(v1[0], v1[1]); w.w = pk2(v1[2], v1[3]);
                        *(GAS u32x4*)(rowp + bj * HALF) = w; } }
        }
    }
};

struct EpiQ {
    static constexpr bool PERM = true, KEEP = false;
    GAS bf16* q; const GAS float* rs; const GAS float* cosb; const GAS float* sinb;
    __device__ __forceinline__ void operator()(AccT& acc, const Unit& u, int wr, int wc, int fr, int fq) const {
        { const int ln = lane_id_opaque(); fr = ln & 15; fq = ln >> 4; }
        const int row0 = u.pm * BM + wr * 64 + fr; const float qs = 0.07216878364870322f * LOG2E;
        float sc[2][4];
#pragma unroll
        for (int ai = 0; ai < 2; ++ai)
#pragma unroll
            for (int m = 0; m < 4; ++m) sc[ai][m] = rs[2 * (row0 + ai * HALF + m * 16)] * qs;
#pragma unroll
        for (int bj = 0; bj < 2; ++bj) { const int c0 = u.pn * BM + bj * HALF + wc * 32 + 8 * fq; const int within = c0 % 192; const bool rope = within >= 128; const int j0 = rope ? (within - 128) >> 1 : 0;
#pragma unroll
            for (int am = 0; am < 2; ++am) { f32x4 cs[4], sn[4];
                if (rope) {
#pragma unroll
                    for (int m = 0; m < 4; ++m) { const int pos = (row0 + am * HALF + m * 16) & (SEQ - 1); cs[m] = *(const GAS f32x4*)(cosb + pos * 32 + j0); sn[m] = *(const GAS f32x4*)(sinb + pos * 32 + j0); } }
#pragma unroll
                for (int m = 0; m < 4; ++m) { const int ai = am; const int row = row0 + ai * HALF + m * 16;
                    f32x4 v0 = acc[ai][bj][m][0] * sc[ai][m], v1 = acc[ai][bj][m][1] * sc[ai][m];
                    if (rope) { f32x4 o0, o1;
                        o0[0] = v0[0] * cs[m][0] - v0[1] * sn[m][0]; o0[1] = v0[1] * cs[m][0] + v0[0] * sn[m][0];
                        o0[2] = v0[2] * cs[m][1] - v0[3] * sn[m][1]; o0[3] = v0[3] * cs[m][1] + v0[2] * sn[m][1];
                        o1[0] = v1[0] * cs[m][2] - v1[1] * sn[m][2]; o1[1] = v1[1] * cs[m][2] + v1[0] * sn[m][2];
                        o1[2] = v1[2] * cs[m][3] - v1[3] * sn[m][3]; o1[3] = v1[3] * cs[m][3] + v1[2] * sn[m][3];
                        v0 = o0; v1 = o1; }
                    u32x4 w; w.x = pk2(v0[0], v0[1]); w.y = pk2(v0[2], v0[3]); w.z = pk2(v1[0], v1[1]); w.w = pk2(v1[2], v1[3]);
                    *(GAS u32x4*)(q + (size_t)row * 768 + c0) = w; } } }
    }
};

struct EpiKV {
    static constexpr bool PERM = true, KEEP = false;
    GAS bf16* kn; GAS bf16* vt; const GAS float* rs;
    __device__ __forceinline__ void operator()(AccT& acc, const Unit& u, int wr, int wc, int fr, int fq) const {
        { const int ln = lane_id_opaque(); fr = ln & 15; fq = ln >> 4; }
        const int row0 = u.pm * BM + wr * 64 + fr;
        float sc[2][4];
        { const GAS float* rp = rs + 2 * row0 + 1;
#pragma unroll
        for (int ai = 0; ai < 2; ++ai)
#pragma unroll
            for (int m = 0; m < 4; ++m) sc[ai][m] = rp[2 * (ai * HALF + m * 16)]; }
        if (u.pn < 2) {
#pragma unroll
            for (int ai = 0; ai < 2; ++ai)
#pragma unroll
                for (int m = 0; m < 4; ++m) { const int row = row0 + ai * HALF + m * 16;
#pragma unroll
                    for (int bj = 0; bj < 2; ++bj) { const f32x4 v0 = acc[ai][bj][m][0] * sc[ai][m], v1 = acc[ai][bj][m][1] * sc[ai][m]; const int c0 = u.pn * BM + bj * HALF + wc * 32 + 8 * fq;
                        u32x4 w; w.x = pk2(v0[0], v0[1]); w.y = pk2(v0[2], v0[3]); w.z = pk2(v1[0], v1[1]); w.w = pk2(v1[2], v1[3]);
                        *(GAS u32x4*)(kn + (size_t)row * 512 + c0) = w; } }
        } else {
            const int b = row0 >> 12, s0 = row0 & (SEQ - 1);
#pragma unroll
            for (int bj = 0; bj < 2; ++bj) { const int head = 2 * (u.pn - 2) + bj;
#pragma unroll
                for (int n = 0; n < 2; ++n)
#pragma unroll
                    for (int j = 0; j < 4; ++j) { const int dv = wc * 32 + 8 * fq + 4 * n + j;
                        GAS bf16* p = vt + ((size_t)((b * 4 + head) * 128 + dv)) * SEQ + s0;
#pragma unroll
                        for (int ai = 0; ai < 2; ++ai)
#pragma unroll
                            for (int m = 0; m < 4; ++m) p[ai * HALF + m * 16] = f2bf(acc[ai][bj][m][n][j] * sc[ai][m]); } }
        }
    }
};

struct EpiPool {
    static constexpr bool PERM = true, KEEP = false;
    GAS bf16* br; const GAS float* scale;
    __device__ __forceinline__ void operator()(AccT& acc, const Unit& u, int wr, int wc, int fr, int fq) const {
        { const int ln = lane_id_opaque(); fr = ln & 15; fq = ln >> 4; }
        const int row0 = u.pm * BM + wr * 64 + fr;
#pragma unroll
        for (int bj = 0; bj < 2; ++bj) { const int c0 = u.pn * BM + bj * HALF + wc * 32 + 8 * fq;
            const f32x4 s0 = *(const GAS f32x4*)(scale + c0), s1 = *(const GAS f32x4*)(scale + c0 + 4);
#pragma unroll
            for (int ai = 0; ai < 2; ++ai)
#pragma unroll
                for (int m = 0; m < 4; ++m) { const int row = row0 + ai * HALF + m * 16; const f32x4 v0 = acc[ai][bj][m][0] * s0, v1 = acc[ai][bj][m][1] * s1;
                    u32x4 w; w.x = pk2(v0[0], v0[1]); w.y = pk2(v0[2], v0[3]); w.z = pk2(v1[0], v1[1]); w.w = pk2(v1[2], v1[3]);
                    *(GAS u32x4*)(br + (size_t)row * D + 1536 + c0) = w; } }
    }
};

struct EpiMerge {
    static constexpr bool PERM = true, KEEP = true;
    const GAS bf16* gates; GAS bf16* mg;
    __device__ __forceinline__ void operator()(AccT& acc, const Unit& u, int wr, int wc, int fr, int fq) const {
        int ln; { ln = lane_id_opaque(); fr = ln & 15; fq = ln >> 4; }
        const int br = u.pn >> 3, pn = u.pn & 7; const int row0 = u.pm * BM + wr * 64 + fr; const int c0 = pn * BM + wc * 32 + 8 * fq;
        const GAS bf16* gp = gates + (size_t)((u.pm * 8 + pn) * 4 + br) * 65536 + (wr * 32 + wc) * 512 + ln * 8;
#pragma unroll
        for (int am = 0; am < 4; ++am) { const int ai = am >> 1, mh = (am & 1) * 2; u32x4 gw[2][2];
#pragma unroll
            for (int mm = 0; mm < 2; ++mm)
#pragma unroll
                for (int bj = 0; bj < 2; ++bj) gw[mm][bj] = *(const GAS u32x4*)(gp + (((ai * 2) * 4 + (mh + mm)) * 2 + bj) * 4 * 512);
            if (br < 3) {
#pragma unroll
                for (int mm = 0; mm < 2; ++mm)
#pragma unroll
                    for (int bj = 0; bj < 2; ++bj) { acc[ai][bj][mh + mm][0] *= ld4bf_lo(gw[mm][bj]); acc[ai][bj][mh + mm][1] *= ld4bf_hi(gw[mm][bj]); }
            } else {
#pragma unroll
                for (int mm = 0; mm < 2; ++mm) { const int m = mh + mm; const int row = row0 + ai * HALF + m * 16;
#pragma unroll
                    for (int bj = 0; bj < 2; ++bj) { const f32x4 v0 = acc[ai][bj][m][0] * ld4bf_lo(gw[mm][bj]), v1 = acc[ai][bj][m][1] * ld4bf_hi(gw[mm][bj]);
                        u32x4 w; w.x = pk2(v0[0], v0[1]); w.y = pk2(v0[2], v0[3]); w.z = pk2(v1[0], v1[1]); w.w = pk2(v1[2], v1[3]);
                        *(GAS u32x4*)(mg + (size_t)row * D + c0 + bj * HALF) = w;
                        acc[ai][bj][m][0] = (f32x4){0.f, 0.f, 0.f, 0.f}; acc[ai][bj][m][1] = (f32x4){0.f, 0.f, 0.f, 0.f}; } }
            }
            asm volatile("" ::: "memory"); }
    }
};

struct EpiOut {
    static constexpr bool PERM = true, KEEP = false;
    const GAS float* x; GAS float* y; GAS bf16* yb; GAS float* st;
    __device__ __forceinline__ void operator()(AccT& acc, const Unit& u, int wr, int wc, int fr, int fq) const {
        { const int ln = lane_id_opaque(); fr = ln & 15; fq = ln >> 4; }
        const int row0 = u.pm * BM + wr * 64 + fr, col0 = u.pn * BM + wc * 32 + 8 * fq;
#pragma unroll
        for (int am = 0; am < 4; ++am) { const int ai = am >> 1, mh = (am & 1) * 2; f32x4 xv[2][2][2];
#pragma unroll
            for (int mm = 0; mm < 2; ++mm)
#pragma unroll
                for (int bj = 0; bj < 2; ++bj) { const size_t ro = (size_t)(row0 + ai * HALF + (mh + mm) * 16) * D + col0 + bj * HALF; xv[mm][bj][0] = *(const GAS f32x4*)(x + ro); xv[mm][bj][1] = *(const GAS f32x4*)(x + ro + 4); }
#pragma unroll
            for (int mm = 0; mm < 2; ++mm) { const int m = mh + mm; const int row = row0 + ai * HALF + m * 16; const size_t ro = (size_t)row * D + col0; float s1 = 0.f, s2 = 0.f;
#pragma unroll
                for (int bj = 0; bj < 2; ++bj) {
                    const f32x4 v0 = xv[mm][bj][0] * DN_ALPHA + acc[ai][bj][m][0], v1 = xv[mm][bj][1] * DN_ALPHA + acc[ai][bj][m][1];
                    *(GAS f32x4*)(y + ro + bj * HALF) = v0; *(GAS f32x4*)(y + ro + bj * HALF + 4) = v1;
                    *(GAS u32x4*)(yb + ro + bj * HALF) = (u32x4){pk2(v0[0], v0[1]), pk2(v0[2], v0[3]), pk2(v1[0], v1[1]), pk2(v1[2], v1[3])};
                    s1 += (v0[0] + v0[1]) + (v0[2] + v0[3]) + (v1[0] + v1[1]) + (v1[2] + v1[3]);
                    s2 += (v0[0] * v0[0] + v0[1] * v0[1]) + (v0[2] * v0[2] + v0[3] * v0[3]) + (v1[0] * v1[0] + v1[1] * v1[1]) + (v1[2] * v1[2] + v1[3] * v1[3]); }
                s1 += __shfl_xor(s1, 16); s2 += __shfl_xor(s2, 16); s1 += __shfl_xor(s1, 32); s2 += __shfl_xor(s2, 32);
                if (fq == 0) { __hip_atomic_fetch_add(st + 2 * row, s1, __ATOMIC_RELAXED, __HIP_MEMORY_SCOPE_AGENT); __hip_atomic_fetch_add(st + 2 * row + 1, s2, __ATOMIC_RELAXED, __HIP_MEMORY_SCOPE_AGENT); } }
            asm volatile("" ::: "memory"); }
    }
};

struct EpiScore {
    static constexpr bool PERM = true, KEEP = false;
    GAS bf16* c; const GAS float* st; const GAS float* cs; const GAS float* bw;
    __device__ __forceinline__ void operator()(AccT& acc, const Unit& u, int wr, int wc, int fr, int fq) const {
        { const int ln = lane_id_opaque(); fr = ln & 15; fq = ln >> 4; }
        const int row0 = u.pm * BM + wr * 64 + fr, col0 = u.pn * BM + wc * 32 + 8 * fq;
        f32x4 cv[2][2], bv[2][2];
#pragma unroll
        for (int bj = 0; bj < 2; ++bj)
#pragma unroll
            for (int n = 0; n < 2; ++n) { cv[bj][n] = *(const GAS f32x4*)(cs + col0 + bj * HALF + n * 4); bv[bj][n] = *(const GAS f32x4*)(bw + col0 + bj * HALF + n * 4); }
        float sa[2][4], sb[2][4];
#pragma unroll
        for (int ai = 0; ai < 2; ++ai)
#pragma unroll
            for (int m = 0; m < 4; ++m) { const int row = row0 + ai * HALF + m * 16; sa[ai][m] = st[2 * row]; sb[ai][m] = st[2 * row + 1]; }
#pragma unroll
        for (int ai = 0; ai < 2; ++ai)
#pragma unroll
            for (int m = 0; m < 4; ++m) { const int row = row0 + ai * HALF + m * 16; const size_t ro = (size_t)row * D + col0;
                const float mu = sa[ai][m] * (1.0f / D), var = sb[ai][m] * (1.0f / D) - mu * mu, rs = 1.0f / sqrtf(var + NORM_EPS);
#pragma unroll
                for (int bj = 0; bj < 2; ++bj) { const f32x4 v0 = (acc[ai][bj][m][0] - mu * cv[bj][0]) * rs + bv[bj][0], v1 = (acc[ai][bj][m][1] - mu * cv[bj][1]) * rs + bv[bj][1];
                    *(GAS u32x4*)(c + ro + bj * HALF) = (u32x4){pk2(v0[0], v0[1]), pk2(v0[2], v0[3]), pk2(v1[0], v1[1]), pk2(v1[2], v1[3])}; } }
    }
};
}
#define XB_TMO      128
#define XB_XCNT(j)  (256  + 64 * (j))
#define XB_XSUB(j)  (1280 + 64 * (j))
#define XB_XGEN(j)  (2304 + 64 * (j))
#define XB_TOP      3328
#define XB_TOPGEN   3392
#define XCD_BAR_WORDS 3456
#define XB_SPIN_CAP (1u << 20)

__device__ __forceinline__ unsigned xb_ld(unsigned* p)              { return __hip_atomic_load(p, __ATOMIC_RELAXED, __HIP_MEMORY_SCOPE_AGENT); }
__device__ __forceinline__ unsigned xb_add(unsigned* p, unsigned v) { return __hip_atomic_fetch_add(p, v, __ATOMIC_RELAXED, __HIP_MEMORY_SCOPE_AGENT); }
__device__ __forceinline__ unsigned xb_xcc_id() { return (unsigned)__builtin_amdgcn_s_getreg((3 << 11) | 20) & 0xFu; }
#define XB_SPIN(cond, bar) do { unsigned _sp = 0; while (cond) { __builtin_amdgcn_s_sleep(1); \
    if ((++_sp & 255u) == 0u) { if (xb_ld(&(bar)[XB_TMO])) break; if (_sp > XB_SPIN_CAP) { atomicAdd(&(bar)[XB_TMO], 1u); break; } } } } while (0)

struct XcdBarrier {
    unsigned* bar; unsigned x;
    volatile LAS unsigned* st;
    int wave;
};
#define XB_LEADER(b) ((b).wave == 0 && lane_id_opaque() == 0)
__device__ __forceinline__ XcdBarrier xcd_barrier_post(unsigned* bar, volatile LAS unsigned* st, int wave) {
    XcdBarrier b; b.bar = bar; b.x = xb_xcc_id(); b.st = st; b.wave = wave;
    if (XB_LEADER(b)) (void)xb_add(&bar[XB_XCNT(b.x)], 1u);
    return b;
}
__device__ __forceinline__ void xcd_barrier_complete(unsigned* bar, unsigned x, unsigned& nloc, unsigned& nx) {
    const unsigned G = gridDim.x * gridDim.y * gridDim.z;
    unsigned sum, cnt, mine, sp = 0u;
    for (;;) {
        sum = 0u; cnt = 0u; mine = 0u;
#pragma unroll
        for (unsigned j = 0; j < 16; ++j) { const unsigned c = xb_ld(&bar[XB_XCNT(j)]); sum += c; cnt += (c > 0u) ? 1u : 0u; mine = (j == x) ? c : mine; }
        if (sum == G) break;
        __builtin_amdgcn_s_sleep(1);
        if ((++sp & 255u) == 0u) { if (xb_ld(&bar[XB_TMO])) break; if (sp > XB_SPIN_CAP) { atomicAdd(&bar[XB_TMO], 1u); break; } }
    }
    nloc = mine > 0u ? mine : 1u; nx = cnt > 0u ? cnt : 1u;
}
__device__ __forceinline__ void xcd_barrier(const XcdBarrier& b) {
    asm volatile("s_waitcnt vmcnt(0)" ::: "memory");
    __syncthreads();
    if (XB_LEADER(b)) {
        unsigned* bar = b.bar;
        __builtin_amdgcn_s_waitcnt(0);
        unsigned nloc = b.st[0], nx = b.st[1];
        if (nloc == 0u) { xcd_barrier_complete(bar, b.x, nloc, nx); b.st[0] = nloc; b.st[1] = nx; }
        const unsigned old = xb_add(&bar[XB_XSUB(b.x)], 1u);
        const unsigned gen = old / nloc;
        if (old + 1u == (gen + 1u) * nloc) {
            __builtin_amdgcn_fence(__ATOMIC_RELEASE, "agent");
            asm volatile("s_waitcnt vmcnt(0)" ::: "memory");
            const unsigned og = xb_add(&bar[XB_TOP], 1u);
            const unsigned tg = og / nx;
            if (og + 1u == (tg + 1u) * nx) xb_add(&bar[XB_TOPGEN], 1u);
            else XB_SPIN(xb_ld(&bar[XB_TOPGEN]) == tg, bar);
            __builtin_amdgcn_fence(__ATOMIC_ACQUIRE, "agent");
            xb_add(&bar[XB_XGEN(b.x)], 1u);
            asm volatile("s_waitcnt vmcnt(0)" ::: "memory");
        } else {
            XB_SPIN(xb_ld(&bar[XB_XGEN(b.x)]) == gen, bar);
            __builtin_amdgcn_fence(__ATOMIC_ACQUIRE, "agent");
            asm volatile("s_waitcnt vmcnt(0)" ::: "memory");
        }
    }
    __syncthreads();
}

struct Args {
    const float* in[20]; float* out; unsigned char* ws; int ph_lo, ph_hi;
};
struct Frame {
    LAS unsigned char* lds;
    int tid, lane, wave, vcu, G;
    GAS unsigned char* ws;
};

template <class RowMap>
DI void transpose_item(const GAS float* W, int ldw, int k0, int n0, GAS bf16* WT, int ldk, int kdst0, const GAS float* kgain, const RowMap& rm, LAS float* scr, int lane) {
#pragma unroll
    for (int i = 0; i < 8; ++i) { const int kk = 8 * i + (lane >> 3), c4 = lane & 7; f32x4 v = *(const GAS f32x4*)(W + (size_t)(k0 + kk) * ldw + n0 + 4 * c4); if (kgain) v *= kgain[k0 + kk];
        LAS float* d = scr + kk * 33 + 4 * c4; d[0] = v[0]; d[1] = v[1]; d[2] = v[2]; d[3] = v[3]; }
    LDS_WAIT(); asm volatile("" ::: "memory");
    const int c = lane & 7;
#pragma unroll
    for (int j = 0; j < 4; ++j) { const int n = (lane >> 3) + 8 * j; const LAS float* s = scr + (8 * c) * 33 + n;
        u32x4 o; o.x = pk2(s[0 * 33], s[1 * 33]); o.y = pk2(s[2 * 33], s[3 * 33]); o.z = pk2(s[4 * 33], s[5 * 33]); o.w = pk2(s[6 * 33], s[7 * 33]);
        *(GAS u32x4*)(WT + (size_t)rm(n0 + n) * ldk + kdst0 + k0 + 8 * c) = o; }
    LDS_WAIT(); asm volatile("" ::: "memory");
}
struct RmIdent { int off; DI int operator()(int n) const { return n + off; } };
struct RmWin { DI int operator()(int n) const { if (n < NHM) return n + NGATE; const int g = n - NHM, i = g >> 11, d = g & 2047;
    return 256 * (d >> 6) + 128 * (i >> 1) + 32 * ((d & 63) >> 4) + 8 * ((d >> 2) & 3) + 4 * (i & 1) + (d & 3); } };
struct RmQup { DI int operator()(int n) const { const int h = n / 192, w = n % 192; if (w < 128) return n; const int r = w - 128; const int j = r & 31, e = r >> 5; return h * 192 + 128 + 2 * j + e; } };
struct RmKvup { DI int operator()(int n) const { const int h = n >> 8, e = (n >> 7) & 1, j = n & 127; return e * 512 + h * 128 + j; } };

DI void zero_row_bytes(GAS void* p, int nbytes, int lane) { GAS u32x4* q = (GAS u32x4*)p; for (int i = lane; i < nbytes / 16; i += 64) q[i] = (u32x4){0u, 0u, 0u, 0u}; }

DI void composite_item(const GAS float* wq, const GAS float* sk, const GAS float* g1, const GAS float* b1, GAS bf16* wpq, GAS float* cs, GAS float* bw, int hp, int dblk, int lane) {
    const int p = hp & 1, r = lane & 31, hb = lane >> 5, d0 = dblk * 32;
    f32x16 acc[4];
#pragma unroll
    for (int nb = 0; nb < 4; ++nb) acc[nb] = zero16();
#pragma unroll 2
    for (int s = 0; s < 8; ++s) {
        const GAS float* bp = wq + (size_t)(d0 + r) * D + hp * 128 + 16 * s + 8 * hb;
        const f32x4 b0 = *(const GAS f32x4*)bp, b1v = *(const GAS f32x4*)(bp + 4);
        u32x4 bwv = {pk2(b0[0], b0[1]), pk2(b0[2], b0[3]), pk2(b1v[0], b1v[1]), pk2(b1v[2], b1v[3])};
        const bf16x8 bf = __builtin_bit_cast(bf16x8, bwv);
#pragma unroll
        for (int nb = 0; nb < 4; ++nb) {
            const GAS float* ap = sk + ((size_t)p * 128 + 32 * nb + r) * 128 + 16 * s + 8 * hb;
            const f32x4 a0 = *(const GAS f32x4*)ap, a1 = *(const GAS f32x4*)(ap + 4);
            u32x4 aw = {pk2(a0[0], a0[1]), pk2(a0[2], a0[3]), pk2(a1[0], a1[1]), pk2(a1[2], a1[3])};
            acc[nb] = MFMA32(__builtin_bit_cast(bf16x8, aw), bf, acc[nb]);
        }
    }
    const float gd = g1[d0 + r], bd = b1[d0 + r];
#pragma unroll
    for (int nb = 0; nb < 4; ++nb)
#pragma unroll
        for (int i = 0; i < 16; ++i) { const int n = 32 * nb + crow(i, hb); const bf16 wb = f2bf(acc[nb][i] * gd); wpq[(size_t)(hp * 128 + n) * D + d0 + r] = wb;
            float c = bf2f(wb), b = acc[nb][i] * bd;
#pragma unroll
            for (int o = 1; o < 32; o <<= 1) { c += __shfl_xor(c, o); b += __shfl_xor(b, o); }
            if (r == 0) { __hip_atomic_fetch_add(cs + hp * 128 + n, c, __ATOMIC_RELAXED, __HIP_MEMORY_SCOPE_AGENT); __hip_atomic_fetch_add(bw + hp * 128 + n, b, __ATOMIC_RELAXED, __HIP_MEMORY_SCOPE_AGENT); } }
}

DI void p0_prologue(Frame& F, const Args& a) {
    LAS float* scr = (LAS float*)(F.lds + F.wave * 16384);
    const int gw = F.vcu * NWAVES + F.wave, NGW = F.G * NWAVES, lane = F.lane;
    unsigned GAS char* ws = F.ws;
    constexpr int I_WIN = (D / 64) * (IN_DIM / 32);
    constexpr int I_QUP = (512 / 64) * (768 / 32);
    constexpr int I_KVUP = (256 / 64) * (1024 / 32);
    constexpr int I_POOL = 4 * 2 * 4;
    constexpr int I_BR = 4 * (512 / 64) * (D / 32);
    constexpr int I_OUT = (D / 64) * (D / 32);
    constexpr int I_LAYER = I_WIN + I_QUP + I_KVUP + I_POOL + I_BR + I_OUT;
    for (int it = gw; it < DEPTH * I_LAYER; it += NGW) {
        const int l = it / I_LAYER; int r = it % I_LAYER;
        if (r < I_WIN) { const int nblk = IN_DIM / 32, kb = r / nblk, nb = r % nblk;
            transpose_item(((const GAS float*)a.in[1]) + (size_t)l * D * IN_DIM, IN_DIM, 64 * kb, 32 * nb, (GAS bf16*)(ws + WS_WIN + l * SZ_WIN), D, 0, nullptr, RmWin{}, scr, lane); continue; } r -= I_WIN;
        if (r < I_QUP) { const int nblk = 768 / 32, kb = r / nblk, nb = r % nblk;
            transpose_item(((const GAS float*)a.in[5]) + (size_t)l * 512 * 768, 768, 64 * kb, 32 * nb, (GAS bf16*)(ws + WS_WQUP + l * SZ_WQUP), 512, 0, ((const GAS float*)a.in[4]) + l * 512, RmQup{}, scr, lane); continue; } r -= I_QUP;
        if (r < I_KVUP) { const int nblk = 1024 / 32, kb = r / nblk, nb = r % nblk;
            transpose_item(((const GAS float*)a.in[7]) + (size_t)l * 256 * 1024, 1024, 64 * kb, 32 * nb, (GAS bf16*)(ws + WS_WKVUP + l * SZ_WKVUP), 256, 0, ((const GAS float*)a.in[6]) + l * 256, RmKvup{}, scr, lane); continue; } r -= I_KVUP;
        if (r < I_POOL) { const int g = r >> 3, kb = (r >> 2) & 1, nb = r & 3;
            transpose_item(((const GAS float*)a.in[8]) + ((size_t)l * 4 + g) * 128 * 128, 128, 64 * kb, 32 * nb, (GAS bf16*)(ws + WS_WPOOL + l * SZ_WPOOL), 512, g * 128, nullptr, RmIdent{g * 128}, scr, lane); continue; } r -= I_POOL;
        if (r < I_BR) { const int i = r / 512, rr = r % 512, nblk = D / 32, kb = rr / nblk, nb = rr % nblk;
            transpose_item(((const GAS float*)a.in[10]) + ((size_t)l * 4 + i) * 512 * D, D, 64 * kb, 32 * nb, (GAS bf16*)(ws + WS_WBR + l * SZ_WBR), 512, 0, nullptr, RmIdent{i * D}, scr, lane); continue; } r -= I_BR;
        { const int nblk = D / 32, kb = r / nblk, nb = r % nblk;
            transpose_item(((const GAS float*)a.in[11]) + (size_t)l * D * D, D, 64 * kb, 32 * nb, (GAS bf16*)(ws + WS_WOUT + l * SZ_WSQ), D, 0, nullptr, RmIdent{0}, scr, lane); }
    }
    for (int it = gw; it < DEPTH * (192 + 512); it += NGW) {
        const int l = it / 704, r = it % 704;
        if (r < 192) zero_row_bytes(ws + WS_WIN + l * SZ_WIN + (size_t)(IN_DIM + r) * D * 2, D * 2, lane);
        else { const int n = r - 192, g = n >> 7; GAS bf16* row = (GAS bf16*)(ws + WS_WPOOL + l * SZ_WPOOL) + (size_t)n * 512;
            for (int gb = 0; gb < 4; ++gb) if (gb != g && lane < 16) *(GAS u32x4*)(row + gb * 128 + lane * 8) = (u32x4){0u, 0u, 0u, 0u}; }
    }
    for (int it = gw; it < DEPTH * 16 * 64; it += NGW) {
        const int l = it >> 10, hp = (it >> 6) & 15, dblk = it & 63;
        composite_item(((const GAS float*)a.in[14]) + (size_t)l * D * D, ((const GAS float*)a.in[15]) + (size_t)l * 2 * 128 * 128, ((const GAS float*)a.in[12]) + l * D, ((const GAS float*)a.in[13]) + l * D,
                       (GAS bf16*)(ws + WS_WPQ + l * SZ_WSQ), (GAS float*)(ws + WS_CTL) + CW_CS + l * 2048, (GAS float*)(ws + WS_CTL) + CW_BW + l * 2048, hp, dblk, lane);
    }
    { GAS float* cosb = (GAS float*)(ws + WS_ROPE); GAS float* sinb = cosb + SEQ * 32;
      for (int i = gw * 64 + lane; i < SEQ * 32; i += NGW * 64) { const int pos = i >> 5, j = i & 31;
          const float inv = fast_exp2(-(float)j * 0.41524101186092029f);
          const float ang = (float)pos * inv; double rev = (double)ang * 0.15915494309189535; rev -= __builtin_rint(rev);
          cosb[i] = __builtin_amdgcn_cosf((float)rev); sinb[i] = __builtin_amdgcn_sinf((float)rev); } }
    { const size_t gt = (size_t)gw * 64 + lane, NT = (size_t)NGW * 64;
      { const GAS float* src = ((const GAS float*)a.in[0]); GAS bf16* dst = (GAS bf16*)(ws + WS_XB); const size_t n8 = (size_t)T * D / 8;
        for (size_t i = gt; i < n8; i += NT) { const f32x4 v0 = *(const GAS f32x4*)(src + i * 8), v1 = *(const GAS f32x4*)(src + i * 8 + 4);
            *(GAS u32x4*)(dst + i * 8) = (u32x4){pk2(v0[0], v0[1]), pk2(v0[2], v0[3]), pk2(v1[0], v1[1]), pk2(v1[2], v1[3])}; } }
#pragma unroll 1
      for (int tb = 0; tb < 2; ++tb) { const GAS float* src = (const GAS float*)a.in[16 + tb]; GAS unsigned char* dst = ws + (tb ? WS_TABV : WS_TABU); const size_t n32 = (size_t)DEPTH * NEXP * 64;
        const float scl = tb ? V_SCALE : U_SCALE;
        for (size_t i = gt; i < n32; i += NT) { const size_t row = i >> 6; const int ln = (int)(i & 63);
            f32x16 va, vb; const GAS float* sp = src + row * D + 4 * ln;
#pragma unroll
            for (int q = 0; q < 4; ++q) { const f32x4 x = __builtin_nontemporal_load((const GAS f32x4*)(sp + 256 * q)) * scl, y = __builtin_nontemporal_load((const GAS f32x4*)(sp + 256 * (q + 4))) * scl;
#pragma unroll
                for (int e = 0; e < 4; ++e) { va[4 * q + e] = x[e]; vb[4 * q + e] = y[e]; } }
            const u32x6 w = __builtin_amdgcn_cvt_scalef32_2xpk16_fp6_f32(va, vb, 1.0f);
            GAS unsigned char* rp = dst + row * ROWB;
            *(GAS u32x4*)(rp + 16 * ln) = (u32x4){w[0], w[1], w[2], w[3]}; *(GAS u32x2*)(rp + 1024 + 8 * ln) = (u32x2){w[4], w[5]}; } } }
}

DI void elem_chunk(Frame& F, int ch, const GAS bf16* hm, GAS bf16* br, GAS bf16* py, GAS bf16* kpe, GAS float* rs, GAS float* st, const GAS float* convw, const GAS float* cosb, const GAS float* sinb) {
    const int T0 = ch * 64, tid = F.tid, lane = F.lane;
    if (tid < 128) st[T0 * 2 + tid] = 0.f;
    const int t0 = T0 + 8 * F.wave, pos0 = t0 & (SEQ - 1);
    const u32x4 zz = {0u, 0u, 0u, 0u};
    { f32x4 w0[3], w1[3];
#pragma unroll
      for (int d = 0; d < 3; ++d) { w0[d] = *(const GAS f32x4*)(convw + d * 512 + 8 * lane); w1[d] = *(const GAS f32x4*)(convw + d * 512 + 8 * lane + 4); }
#pragma unroll 1
      for (int h = 0; h < 2; ++h) { const int tb = t0 + 4 * h;
          const GAS bf16* rp = hm + (size_t)(tb - 2) * HM_LD + 8 * lane;
          u32x4 uw[6], cw[6], bw[4];
#pragma unroll
          for (int k = 0; k < 6; ++k) { uw[k] = *(const GAS u32x4*)(rp + (size_t)k * HM_LD + C_CONVU); cw[k] = *(const GAS u32x4*)(rp + (size_t)k * HM_LD + C_CONVC); }
#pragma unroll
          for (int k = 0; k < 4; ++k) bw[k] = *(const GAS u32x4*)(rp + (size_t)(k + 2) * HM_LD + C_CONVB);
          f32x4 z0[6], z1[6];
#pragma unroll
          for (int k = 0; k < 6; ++k) { const bool ok = (pos0 + 4 * h - 2 + k) >= 0; const u32x4 a = ok ? uw[k] : zz, c = ok ? cw[k] : zz; z0[k] = ld4bf_lo(a) * ld4bf_lo(c); z1[k] = ld4bf_hi(a) * ld4bf_hi(c); }
#pragma unroll
          for (int k = 0; k < 4; ++k) { f32x4 y0 = w0[0] * z0[k] + w0[1] * z0[k + 1] + w0[2] * z0[k + 2], y1 = w1[0] * z1[k] + w1[1] * z1[k + 1] + w1[2] * z1[k + 2];
              y0 *= ld4bf_lo(bw[k]); y1 *= ld4bf_hi(bw[k]);
              *(GAS u32x4*)(br + (size_t)(tb + k) * D + 8 * lane) = (u32x4){pk2(y0[0], y0[1]), pk2(y0[2], y0[3]), pk2(y1[0], y1[1]), pk2(y1[2], y1[3])}; }
          asm volatile("" ::: "memory"); } }
    { const int g = lane >> 4, w = 2 << g;
#pragma unroll 1
      for (int h = 0; h < 2; ++h) { const int tb = t0 + 4 * h;
          const GAS bf16* rp = hm + (size_t)(tb - 15) * HM_LD + C_POOL + 8 * lane;
          u32x4 x[19];
#pragma unroll
          for (int k = 0; k < 19; ++k) x[k] = *(const GAS u32x4*)(rp + (size_t)k * HM_LD);
#pragma unroll
          for (int k = 0; k < 15; ++k) { const bool ok = (pos0 + 4 * h - 15 + k) >= 0; x[k] = ok ? x[k] : zz; }
#pragma unroll
          for (int jj = 0; jj < 4; ++jj) { const int pos = pos0 + 4 * h + jj; const int cnt = (pos + 1 < w) ? pos + 1 : w;
              const f32x4 u0 = ld4bf_lo(x[15 + jj]), u1 = ld4bf_hi(x[15 + jj]);
              f32x4 s0 = u0 + ld4bf_lo(x[14 + jj]), s1 = u1 + ld4bf_hi(x[14 + jj]);
              if (g >= 1) {
#pragma unroll
                  for (int d = 2; d < 4; ++d) { s0 += ld4bf_lo(x[15 + jj - d]); s1 += ld4bf_hi(x[15 + jj - d]); } }
              if (g >= 2) {
#pragma unroll
                  for (int d = 4; d < 8; ++d) { s0 += ld4bf_lo(x[15 + jj - d]); s1 += ld4bf_hi(x[15 + jj - d]); } }
              if (g >= 3) {
#pragma unroll
                  for (int d = 8; d < 16; ++d) { s0 += ld4bf_lo(x[15 + jj - d]); s1 += ld4bf_hi(x[15 + jj - d]); } }
              const float ic = 1.0f / (float)cnt; s0 = s0 * ic - u0; s1 = s1 * ic - u1;
              *(GAS u32x4*)(py + (size_t)(tb + jj) * 512 + 8 * lane) = (u32x4){pk2(s0[0], s0[1]), pk2(s0[2], s0[3]), pk2(s1[0], s1[1]), pk2(s1[2], s1[3])}; }
          asm volatile("" ::: "memory"); } }
    { u32x4 qw[8], kw[8]; float x1[8], x2[8], cc[8], ss[8];
#pragma unroll
      for (int k = 0; k < 8; ++k) { const int t = t0 + k; const GAS bf16* rp = hm + (size_t)t * HM_LD; const int pos = t & (SEQ - 1);
          qw[k] = *(const GAS u32x4*)(rp + C_CQ + 8 * lane); kw[k] = *(const GAS u32x4*)(rp + C_CKV + 8 * (lane & 31));
          x1[k] = bf2f(rp[C_KR + (lane & 31)]); x2[k] = bf2f(rp[C_KR + 32 + (lane & 31)]); cc[k] = cosb[pos * 32 + (lane & 31)]; ss[k] = sinb[pos * 32 + (lane & 31)]; }
#pragma unroll
      for (int k = 0; k < 8; ++k) { const int t = t0 + k; const f32x4 a = ld4bf_lo(qw[k]), b = ld4bf_hi(qw[k]), c = ld4bf_lo(kw[k]), d = ld4bf_hi(kw[k]);
          float sq = (a[0] * a[0] + a[1] * a[1]) + (a[2] * a[2] + a[3] * a[3]) + (b[0] * b[0] + b[1] * b[1]) + (b[2] * b[2] + b[3] * b[3]);
          float skv = (c[0] * c[0] + c[1] * c[1]) + (c[2] * c[2] + c[3] * c[3]) + (d[0] * d[0] + d[1] * d[1]) + (d[2] * d[2] + d[3] * d[3]);
          skv = (lane < 32) ? skv : 0.f;
          sq = wave_sum(sq); skv = wave_sum(skv);
          if (lane == 0) { rs[2 * t] = 1.0f / sqrtf(sq * (1.0f / 512.0f) + NORM_EPS); rs[2 * t + 1] = 1.0f / sqrtf(skv * (1.0f / 256.0f) + NORM_EPS); }
          if (lane < 32) *(GAS unsigned*)(kpe + (size_t)t * 64 + 2 * lane) = pk2(x1[k] * cc[k] - x2[k] * ss[k], x2[k] * cc[k] + x1[k] * ss[k]); } }
}

constexpr int SWA_KROW = 144, SWA_VROW = 520, SWA_VOFF = 256 * SWA_KROW;
DI void swa_unit(Frame& F, int unit, const GAS bf16* hm, GAS bf16* br, const GAS float* sinks) {
    const int kvh = unit & 1, nb = (unit >> 1) & 31, b = unit >> 6;
    const int t0 = b * SEQ + nb * 128, tid = F.tid, lane = F.lane, r = lane & 31, hb = lane >> 5;
    LAS unsigned char* lds = F.lds;
    const int g = F.wave >> 1, rh = F.wave & 1, head = kvh * 4 + g;
    bf16x8 qfa[2][4];
#pragma unroll
    for (int rbi = 0; rbi < 2; ++rbi)
#pragma unroll
        for (int s = 0; s < 4; ++s) qfa[rbi][s] = *(const GAS bf16x8*)(hm + (size_t)(t0 + 32 * (2 * rh + rbi) + r) * HM_LD + C_SWAQ + 64 * head + 16 * s + 8 * hb);
#pragma unroll
    for (int k = 0; k < 4; ++k) { const int id = tid + 512 * k, row = id >> 3, ch = id & 7; const bool ok = (nb > 0) || (row >= 128);
        u32x4 kw = {0u, 0u, 0u, 0u}, vw = kw;
        if (ok) { const GAS bf16* rp = hm + (size_t)(t0 - 128 + row) * HM_LD; kw = *(const GAS u32x4*)(rp + C_SWAK + 64 * kvh + 8 * ch); vw = *(const GAS u32x4*)(rp + C_SWAV + 64 * kvh + 8 * ch); }
        *(LAS u32x4*)(lds + row * SWA_KROW + ch * 16) = kw;
        LAS unsigned char* vp = lds + SWA_VOFF + (8 * ch) * SWA_VROW + row * 2;
        *(LAS bf16*)(vp + 0 * SWA_VROW) = (bf16)(vw.x & 0xffffu); *(LAS bf16*)(vp + 1 * SWA_VROW) = (bf16)(vw.x >> 16);
        *(LAS bf16*)(vp + 2 * SWA_VROW) = (bf16)(vw.y & 0xffffu); *(LAS bf16*)(vp + 3 * SWA_VROW) = (bf16)(vw.y >> 16);
        *(LAS bf16*)(vp + 4 * SWA_VROW) = (bf16)(vw.z & 0xffffu); *(LAS bf16*)(vp + 5 * SWA_VROW) = (bf16)(vw.z >> 16);
        *(LAS bf16*)(vp + 6 * SWA_VROW) = (bf16)(vw.w & 0xffffu); *(LAS bf16*)(vp + 7 * SWA_VROW) = (bf16)(vw.w >> 16); }
    __syncthreads();
    const float slope2 = fast_exp2(-(float)(head + 1)) * LOG2E, sink2 = sinks[head] * LOG2E, qk2 = 0.125f * LOG2E;
#pragma unroll 1
    for (int rbi = 0; rbi < 2; ++rbi) { const int rb = 2 * rh + rbi; const int qrow = t0 + 32 * rb + r;
        bf16x8 qf[4];
#pragma unroll
        for (int s = 0; s < 4; ++s) qf[s] = rbi ? qfa[1][s] : qfa[0][s];
        f32x16 S[5]; float mx = sink2;
#pragma unroll
        for (int tt = 0; tt < 5; ++tt) { const int tl = rb + tt; f32x16 acc = zero16();
#pragma unroll
            for (int s = 0; s < 4; ++s) { const bf16x8 kf = *(const LAS bf16x8*)(lds + (32 * tl + r) * SWA_KROW + (16 * s + 8 * hb) * 2); acc = MFMA32(kf, qf[s], acc); }
#pragma unroll
            for (int i = 0; i < 16; ++i) { const int kb = 32 * tl + crow(i, hb), dist = 128 + 32 * rb + r - kb; const bool ok = (dist >= 0) && (dist < 128) && ((nb > 0) || (kb >= 128));
                const float v = ok ? acc[i] * qk2 - slope2 * (float)dist : -1e30f; acc[i] = v; mx = fmaxf(mx, v); }
            S[tt] = acc; }
        mx = fmaxf(mx, __shfl_xor(mx, 32));
        float den = 0.f; bf16x8 pf[5][2];
#pragma unroll
        for (int tt = 0; tt < 5; ++tt) {
#pragma unroll
            for (int i = 0; i < 16; ++i) { const float p = fast_exp2(S[tt][i] - mx); S[tt][i] = p; den += p; }
#pragma unroll
            for (int s = 0; s < 2; ++s) { u32x4 w = {pk2(S[tt][8 * s], S[tt][8 * s + 1]), pk2(S[tt][8 * s + 2], S[tt][8 * s + 3]), pk2(S[tt][8 * s + 4], S[tt][8 * s + 5]), pk2(S[tt][8 * s + 6], S[tt][8 * s + 7])};
                pf[tt][s] = __builtin_bit_cast(bf16x8, w); } }
        den += __shfl_xor(den, 32); den += fast_exp2(sink2 - mx);
        const float inv = 1.0f / den;
        f32x16 O[2]; O[0] = zero16(); O[1] = zero16();
#pragma unroll
        for (int tt = 0; tt < 5; ++tt) { const int tl = rb + tt;
#pragma unroll
            for (int s = 0; s < 2; ++s)
#pragma unroll
                for (int dvb = 0; dvb < 2; ++dvb) { const LAS unsigned char* vp = lds + SWA_VOFF + (32 * dvb + r) * SWA_VROW + (32 * tl + 16 * s + 4 * hb) * 2;
                    const s16x4 lo = *(const LAS s16x4*)vp, hi = *(const LAS s16x4*)(vp + 16);
                    const bf16x8 vf = __builtin_shufflevector(lo, hi, 0, 1, 2, 3, 4, 5, 6, 7);
                    O[dvb] = MFMA32(vf, pf[tt][s], O[dvb]); } }
        GAS bf16* op = br + (size_t)qrow * D + 512 + 64 * head;
#pragma unroll
        for (int dvb = 0; dvb < 2; ++dvb)
#pragma unroll
            for (int ig = 0; ig < 4; ++ig) { const int dv0 = 32 * dvb + 8 * ig + 4 * hb;
#ifdef DBG_ZERO_SWA
                *(GAS u32x2*)(op + dv0) = (u32x2){0u, 0u}; }
#else
                *(GAS u32x2*)(op + dv0) = (u32x2){pk2(O[dvb][4 * ig] * inv, O[dvb][4 * ig + 1] * inv), pk2(O[dvb][4 * ig + 2] * inv, O[dvb][4 * ig + 3] * inv)}; }
#endif
    }
    __syncthreads();
}
constexpr int MLA_KROW = 400, MLA_VROW = 136, MLA_KBYTES = 64 * MLA_KROW, MLA_STG = MLA_KBYTES + 128 * MLA_VROW;
static_assert(2 * MLA_STG <= RING_BYTES, "MLA stage buffers");

DI void mla_unit(Frame& F, int b, int h, int qblk, const GAS bf16* q, const GAS bf16* kn, const GAS bf16* kpe, const GAS bf16* vt, GAS bf16* br) {
    const int tid = F.tid, lane = F.lane, r = lane & 31, hb = lane >> 5, rg = F.wave & 3, kp = F.wave >> 2;
    LAS unsigned char* lds = F.lds;
    const size_t rowb = (size_t)b * SEQ; const int q0 = qblk * 128;
    const int NS = 2 * (qblk + 1);
    const int kkey0 = tid >> 4, kc0 = tid & 15;
    const int rkey = tid >> 3, rc = tid & 7;
    const int vdv0 = tid >> 3, vc = tid & 7;
    const GAS unsigned char* knb = (const GAS unsigned char*)(kn + rowb * 512 + 128 * h);
    const GAS unsigned char* kpb = (const GAS unsigned char*)(kpe + rowb * 64);
    const GAS unsigned char* vtb = (const GAS unsigned char*)(vt + (size_t)((b * 4 + h) * 128) * SEQ);
    const unsigned knl = (unsigned)(kkey0 * 512 + 8 * kc0) * 2u, kpl = (unsigned)(rkey * 64 + 8 * rc) * 2u, vtl = (unsigned)(vdv0 * SEQ + 8 * vc) * 2u;
    u32x4 sk0A, sk1A, srA, sv0A, sv1A, sk0B, sk1B, srB, sv0B, sv1B;
#define MLA_LOAD(j, X) do { const unsigned ko = (unsigned)(64 * (j)); \
        sk0##X = *(const GAS u32x4*)(knb + (size_t)ko * 1024 + knl); sk1##X = *(const GAS u32x4*)(knb + (size_t)(ko + 32) * 1024 + knl); sr##X = *(const GAS u32x4*)(kpb + (size_t)ko * 128 + kpl); \
        sv0##X = *(const GAS u32x4*)(vtb + (size_t)ko * 2 + vtl); sv1##X = *(const GAS u32x4*)(vtb + (size_t)64 * SEQ * 2 + (size_t)ko * 2 + vtl); } while (0)
#define MLA_STORE(buf, X) do { LAS unsigned char* sb = lds + (buf) * MLA_STG; \
        *(LAS u32x4*)(sb + kkey0 * MLA_KROW + kc0 * 16) = sk0##X; *(LAS u32x4*)(sb + (kkey0 + 32) * MLA_KROW + kc0 * 16) = sk1##X; \
        *(LAS u32x4*)(sb + rkey * MLA_KROW + 256 + rc * 16) = sr##X; \
        LAS unsigned char* vb = sb + MLA_KBYTES + vdv0 * MLA_VROW + vc * 16; \
        *(LAS u32x2*)(vb) = (u32x2){sv0##X.x, sv0##X.y}; *(LAS u32x2*)(vb + 8) = (u32x2){sv0##X.z, sv0##X.w}; \
        *(LAS u32x2*)(vb + 64 * MLA_VROW) = (u32x2){sv1##X.x, sv1##X.y}; *(LAS u32x2*)(vb + 64 * MLA_VROW + 8) = (u32x2){sv1##X.z, sv1##X.w}; } while (0)
    MLA_LOAD(0, A); MLA_LOAD(1, B);
    bf16x8 qf[12];
    { const GAS bf16* qp = q + (rowb + q0 + 32 * rg + r) * 768 + 192 * h + 8 * hb;
#pragma unroll
      for (int s = 0; s < 12; ++s) qf[s] = *(const GAS bf16x8*)(qp + 16 * s); }
    MLA_STORE(0, A);
    __syncthreads();
    float m = -1e30f, lsum = 0.f; f32x16 O[4];
#pragma unroll
    for (int d = 0; d < 4; ++d) O[d] = zero16();
#define MLA_STEP(j, X, Y) do { \
        if ((j) + 1 < NS) MLA_STORE(((j) + 1) & 1, X);        \
        if ((j) + 2 < NS) MLA_LOAD((j) + 2, Y); \
        mla_compute(j); \
        __syncthreads(); } while (0)
    auto mla_compute = [&](int j) __attribute__((always_inline)) {
        const int taup = 2 * j + kp - 4 * qblk;
        if (taup <= rg) {
            const LAS unsigned char* sb = lds + (j & 1) * MLA_STG;
            f32x16 S = zero16();
            const LAS unsigned char* kpn = sb + (32 * kp + r) * MLA_KROW + hb * 16;
            __builtin_amdgcn_s_setprio(1);
#pragma unroll
            for (int s = 0; s < 12; ++s) { const bf16x8 kf = *(const LAS bf16x8*)(kpn + s * 32); S = MFMA32(kf, qf[s], S); }
            __builtin_amdgcn_s_setprio(0);
            if (taup == rg) {
#pragma unroll
                for (int i = 0; i < 16; ++i) if (crow(i, hb) > r) S[i] = -1e30f; }
            float mt = S[0];
#pragma unroll
            for (int i = 1; i < 16; ++i) mt = fmaxf(mt, S[i]);
            mt = fmaxf(mt, __shfl_xor(mt, 32));
            const float mn = fmaxf(m, mt);
            if (__any(mt > m)) {
                const float al = fast_exp2(m - mn); lsum *= al;
#pragma unroll
                for (int d = 0; d < 4; ++d) O[d] *= al; }
            m = mn;
            float ps = 0.f;
#pragma unroll
            for (int i = 0; i < 16; ++i) { const float p = fast_exp2(S[i] - mn); S[i] = p; ps += p; }
            lsum += ps;
            bf16x8 pf[2];
#pragma unroll
            for (int s = 0; s < 2; ++s) { u32x4 w = {pk2(S[8 * s], S[8 * s + 1]), pk2(S[8 * s + 2], S[8 * s + 3]), pk2(S[8 * s + 4], S[8 * s + 5]), pk2(S[8 * s + 6], S[8 * s + 7])}; pf[s] = __builtin_bit_cast(bf16x8, w); }
            const LAS unsigned char* vpn = sb + MLA_KBYTES + r * MLA_VROW + (32 * kp + 4 * hb) * 2;
            __builtin_amdgcn_s_setprio(1);
#pragma unroll
            for (int d = 0; d < 4; ++d)
#pragma unroll
                for (int s = 0; s < 2; ++s) { const LAS unsigned char* vp = vpn + 32 * d * MLA_VROW + 32 * s;
                    const s16x4 lo = *(const LAS s16x4*)vp, hi = *(const LAS s16x4*)(vp + 16);
                    O[d] = MFMA32(__builtin_shufflevector(lo, hi, 0, 1, 2, 3, 4, 5, 6, 7), pf[s], O[d]); }
            __builtin_amdgcn_s_setprio(0);
        }
    };
#pragma unroll 1
    for (int j = 0; j < NS; j += 2) { MLA_STEP(j, B, A); MLA_STEP(j + 1, A, B); }
#undef MLA_STEP
#undef MLA_LOAD
#undef MLA_STORE
    lsum += __shfl_xor(lsum, 32);
    LAS float* xo = (LAS float*)lds;
    LAS float* xm = (LAS float*)(lds + 65536);
    if (kp == 1) {
#pragma unroll
        for (int d = 0; d < 4; ++d)
#pragma unroll
            for (int i = 0; i < 16; ++i) xo[(rg * 64 + d * 16 + i) * 64 + lane] = O[d][i];
        xm[(rg * 2 + 0) * 64 + lane] = m; xm[(rg * 2 + 1) * 64 + lane] = lsum;
    }
    __syncthreads();
    if (kp == 0) {
        const float m1 = xm[(rg * 2 + 0) * 64 + lane], l1 = xm[(rg * 2 + 1) * 64 + lane];
        const float mn = fmaxf(m, m1), a0 = fast_exp2(m - mn), a1 = fast_exp2(m1 - mn);
        const float inv = 1.0f / (lsum * a0 + l1 * a1);
        const float c0 = a0 * inv, c1 = a1 * inv;
        GAS bf16* op = br + (rowb + q0 + 32 * rg + r) * D + 1024 + 128 * h;
#pragma unroll
        for (int d = 0; d < 4; ++d)
#pragma unroll
            for (int ig = 0; ig < 4; ++ig) { float v[4];
#pragma unroll
                for (int e = 0; e < 4; ++e) v[e] = O[d][4 * ig + e] * c0 + xo[(rg * 64 + d * 16 + 4 * ig + e) * 64 + lane] * c1;
                *(GAS u32x2*)(op + 32 * d + 8 * ig + 4 * hb) = (u32x2){pk2(v[0], v[1]), pk2(v[2], v[3])}; }
    }
    __syncthreads();
}

DI void mla_phase(Frame& F, const GAS bf16* q, const GAS bf16* kn, const GAS bf16* kpe, const GAS bf16* vt, GAS bf16* br) {
    for (int p = F.vcu; p < 256; p += F.G) { const int bh = p >> 4, i = p & 15;
        mla_unit(F, bh >> 2, bh & 3, 31 - i, q, kn, kpe, vt, br);
        mla_unit(F, bh >> 2, bh & 3, i, q, kn, kpe, vt, br); }
}
#ifdef PEER_NT
#define NTLD(p) __builtin_nontemporal_load(p)
#define NTST(p, v) __builtin_nontemporal_store((v), (p))
#else
#define NTLD(p) (*(p))
#define NTST(p, v) (*(p) = (v))
#endif
DI void ln1_phase(Frame& F, GAS float* y, GAS bf16* hbv, const GAS float* g, const GAS float* bta) {
    const int gw = F.vcu * NWAVES + F.wave, NGW = F.G * NWAVES, lane = F.lane;
    for (int row = gw; row < T; row += NGW) {
        GAS float* yr = y + (size_t)row * D + 4 * lane; f32x4 v[8]; float s = 0.f;
#pragma unroll
        for (int q = 0; q < 8; ++q) v[q] = *(const GAS f32x4*)(yr + 256 * q);
#pragma unroll
        for (int k = 0; k < 8; ++k) s += (v[k][0] + v[k][1]) + (v[k][2] + v[k][3]);
        const float mean = wave_sum(s) * (1.0f / D); float s2 = 0.f;
#pragma unroll
        for (int k = 0; k < 8; ++k) { v[k] = v[k] - mean; s2 += (v[k][0] * v[k][0] + v[k][1] * v[k][1]) + (v[k][2] * v[k][2] + v[k][3] * v[k][3]); }
        const float rstd = 1.0f / sqrtf(wave_sum(s2) * (1.0f / D) + NORM_EPS);
#pragma unroll
        for (int q = 0; q < 8; ++q) { const int c = 256 * q + 4 * lane;
            const f32x4 o0 = v[q] * rstd * *(const GAS f32x4*)(g + c) + *(const GAS f32x4*)(bta + c);
            *(GAS f32x4*)(yr + 256 * q) = o0;
            *(GAS u32x2*)(hbv + (size_t)row * D + c) = (u32x2){pk2(o0[0], o0[1]), pk2(o0[2], o0[3])}; }
    }
}

DI float gelu_erf(float a) { return 0.5f * a * (1.0f + erff(a * 0.70710678118654752f)); }

constexpr int PEER_G1OFF = 3072, PEER_B1OFF = 4096, PEER_G2OFF = 5120, PEER_B2OFF = 6144;
constexpr int PEER_WLDS = 16384;
DI void ins16k(float (&a)[16], float v) {
#pragma unroll
    for (int k = 15; k >= 1; --k) a[k] = __builtin_amdgcn_fmed3f(a[k - 1], a[k], v);
    a[0] = fmaxf(a[0], v);
}
DI void peer_topk4(LAS unsigned char* wl, const GAS bf16* sc, int tok0, int slot0) {
    const int lane = lane_id_opaque();
    LAS float* LV = (LAS float*)wl; LAS int* LI = (LAS int*)(wl + 4096);
    LAS int* EX = (LAS int*)(wl + 8192); LAS float* GT = (LAS float*)(wl + 12288);
    { float key[16];
#pragma unroll
      for (int k = 0; k < 16; ++k) key[k] = -3.0e38f;
      const int g4 = lane >> 4, c16 = lane & 15;
      const GAS bf16* sp = sc + (size_t)(tok0 + g4) * D + c16 * 8;
      u32x4 sw[16], sv[16];
#pragma unroll
      for (int k = 0; k < 16; ++k) sw[k] = *(const GAS u32x4*)(sp + k * 128);
      LAS u32x4* TL = (LAS u32x4*)wl;
#pragma unroll
      for (int hf = 0; hf < 2; ++hf) {
#pragma unroll
          for (int k = 0; k < 8; ++k) TL[(g4 * 8 + k) * 16 + (c16 ^ k)] = sw[8 * hf + k];
          LDS_WAIT(); asm volatile("" ::: "memory");
          if ((c16 >> 3) == hf) {
#pragma unroll
              for (int n = 0; n < 16; ++n) sv[n] = TL[(g4 * 8 + (c16 & 7)) * 16 + (n ^ (c16 & 7))]; }
          LDS_WAIT(); asm volatile("" ::: "memory"); }
#pragma unroll
      for (int n = 0; n < 16; ++n)
#pragma unroll
          for (int e = 0; e < 4; ++e) { const unsigned w = sv[n][e]; const int i0 = 8 * n + 2 * e;
              ins16k(key, __uint_as_float((w << 16) | (unsigned)(127 - i0)));
              ins16k(key, __uint_as_float((w & 0xffff0000u) | (unsigned)(126 - i0))); }
#pragma unroll
      for (int k = 0; k < 16; ++k) { const unsigned b = __float_as_uint(key[k]); LV[lane * 16 + k] = __uint_as_float(b & 0xffffff80u); LI[lane * 16 + k] = 127 - (int)(b & 127u); } }
    LDS_WAIT(); asm volatile("" ::: "memory");
    if (lane < 32) { const int it0 = (lane >> 3) * 16 + (lane & 7) * 2;
        float s0[16], s1[16];
#pragma unroll
        for (int k = 0; k < 16; ++k) { s0[k] = LV[it0 * 16 + k]; s1[k] = LV[(it0 + 1) * 16 + k]; }
        float key[16];
#pragma unroll
        for (int k = 0; k < 16; ++k) key[k] = -3.0e38f;
#pragma unroll
        for (int a = 0; a < 16; ++a)
#pragma unroll
            for (int b = 0; b < 16; ++b) if ((a + 1) * (b + 1) <= 16) ins16k(key, __uint_as_float((__float_as_uint(s0[a] + s1[b]) & 0xffffff00u) | (unsigned)(255 - (a * 16 + b))));
        float val[16], e[16], den = 0.f; int idx[16];
#pragma unroll
        for (int k = 0; k < 16; ++k) { const unsigned b = __float_as_uint(key[k]); val[k] = __uint_as_float(b & 0xffffff00u); idx[k] = 255 - (int)(b & 255u); }
#pragma unroll
        for (int k = 0; k < 16; ++k) { e[k] = __expf(val[k] - val[0]); den += e[k]; }
        const float inv = 1.0f / den; const int ob = (slot0 + (lane >> 3)) * 128 + (lane & 7) * 16;
#pragma unroll
        for (int k = 0; k < 16; ++k) { const int i1 = LI[it0 * 16 + (idx[k] >> 4)], i2 = LI[(it0 + 1) * 16 + (idx[k] & 15)];
            EX[ob + k] = i1 * 128 + i2; GT[ob + k] = e[k] * inv; } }
    LDS_WAIT(); asm volatile("" ::: "memory");
}

#ifndef PEER_RD
#define PEER_RD 2
#endif
constexpr int PEER_NB = 8;
constexpr int PEER_RDEP = PEER_RD;
#ifdef DUP_LOAD
struct RowFrag { u32x4 a; u32x2 b; u32x4 a2; };
#elif defined(DUP_LD4)
struct RowFrag { u32x4 a; u32x2 b; unsigned a2; };
#else
struct RowFrag { u32x4 a; u32x2 b; };
#endif
DI RowFrag row_load(const GAS unsigned char* tab, int e, int lane) { const GAS unsigned char* rp = tab + (size_t)e * ROWB; RowFrag f; f.a = *(const GAS u32x4*)(rp + 16 * lane); f.b = *(const GAS u32x2*)(rp + 1024 + 8 * lane);
#ifdef DUP_LOAD
    f.a2 = *(const GAS u32x4*)(tab + (size_t)((e + 7777) & 16383) * ROWB + 16 * lane);
#elif defined(DUP_LD4)
    f.a2 = *(const GAS unsigned*)(rp + 4 * lane);
#endif
    return f; }
DI f32x32 row_unpack(const RowFrag& f) { const u32x6 w = {f.a[0], f.a[1], f.a[2], f.a[3], f.b[0], f.b[1]};
#if defined(DUP_LOAD) || defined(DUP_LD4)
    asm volatile("" :: "v"(f.a2));
#endif
#ifdef DUP_UNPACK
    { f32x32 dummy; asm volatile("v_cvt_scalef32_pk32_f32_fp6 %0, %1, 1.0" : "=v"(dummy) : "v"(w)); asm volatile("" :: "v"(dummy)); }
#endif
#ifdef DUP_FMA
    { f32x2 d0 = {0.f, 0.f}, d1 = {1.f, 1.f}; asm volatile("" : "+v"(d0), "+v"(d1));
      for (int i = 0; i < 16; ++i) asm volatile("v_pk_fma_f32 %0, %1, %1, %0" : "+v"(d0) : "v"(d1)); asm volatile("" :: "v"(d0)); }
#endif
    return __builtin_amdgcn_cvt_scalef32_pk32_f32_fp6(w, 1.0f); }

DI void time_sync(unsigned* word, unsigned target, int wave) {
    __syncthreads();
    if (wave == 0 && lane_id_opaque() == 0) { __hip_atomic_fetch_add(word, 1u, __ATOMIC_RELAXED, __HIP_MEMORY_SCOPE_AGENT); unsigned sp = 0;
        while (__hip_atomic_load(word, __ATOMIC_RELAXED, __HIP_MEMORY_SCOPE_AGENT) < target) { __builtin_amdgcn_s_sleep(1); if (++sp > (1u << 22)) break; } }
    __syncthreads();
}
template <class BarT> DI void peer_wg(Frame& F, const BarT& gbar, int tsl, int chunk64, const GAS bf16* sc, const GAS bf16* yb16, const GAS float* hrow, const GAS float* st, const GAS float* g1, const GAS float* b1, const GAS unsigned char* tabu, const GAS unsigned char* tabv, const GAS float* g2, const GAS float* b2, GAS float* xout, GAS bf16* xbout) {
    const int lane = F.lane, w = F.wave; const int tokw = chunk64 * 64 + 8 * w;
    LAS unsigned char* wl = F.lds + w * PEER_WLDS;
    LAS int* EX = (LAS int*)(wl + 8192); LAS float* GT = (LAS float*)(wl + 12288);
    LAS float* AV = (LAS float*)(wl + 1088);
    LAS float* CV = (LAS float*)(wl + 1600);
    LAS int* CN = (LAS int*)(wl + 2112);
    LAS int* BS = (LAS int*)(wl + 2368);
    peer_topk4(wl, sc, tokw, 0);
    peer_topk4(wl, sc, tokw + 4, 4);
    { const int lc = lane_id_opaque();
      *(LAS f32x4*)(wl + PEER_G1OFF + 16 * lc) = *(const GAS f32x4*)(g1 + 256 * w + 4 * lc); *(LAS f32x4*)(wl + PEER_B1OFF + 16 * lc) = *(const GAS f32x4*)(b1 + 256 * w + 4 * lc);
      *(LAS f32x4*)(wl + PEER_G2OFF + 16 * lc) = *(const GAS f32x4*)(g2 + 256 * w + 4 * lc); *(LAS f32x4*)(wl + PEER_B2OFF + 16 * lc) = *(const GAS f32x4*)(b2 + 256 * w + 4 * lc); }
    __syncthreads();
#define PEER_SO(r) ((LAS int*)(wl + ((r) & 1) * 544))
#define PEER_SORT(r) do { LAS int* so_ = PEER_SO(r); CN[lane] = 0; LDS_WAIT(); asm volatile("" ::: "memory"); int ev_[2], pos_[2]; \
        _Pragma("unroll") for (int q = 0; q < 2; ++q) { ev_[q] = EX[(r) * 128 + lane + 64 * q]; pos_[q] = __hip_atomic_fetch_add(&CN[ev_[q] >> 8], 1, __ATOMIC_RELAXED, __HIP_MEMORY_SCOPE_WAVEFRONT); } \
        LDS_WAIT(); asm volatile("" ::: "memory"); \
        { const int c = CN[lane]; int inc = c; _Pragma("unroll") for (int o = 1; o < 64; o <<= 1) { const int t_ = __shfl_up(inc, o); if (lane >= o) inc += t_; } BS[lane] = inc - c; } \
        LDS_WAIT(); asm volatile("" ::: "memory"); \
        _Pragma("unroll") for (int q = 0; q < 2; ++q) so_[BS[ev_[q] >> 8] + pos_[q]] = ev_[q] | ((lane + 64 * q) << 14); \
        if (lane < PEER_NB) so_[128 + lane] = 0; \
        LDS_WAIT(); asm volatile("" ::: "memory"); } while (0)
    RowFrag bu[PEER_RDEP];
    PEER_SORT(0);
    { LAS int* so = PEER_SO(0);
#pragma unroll
      for (int b = 0; b < PEER_RDEP; ++b) bu[b] = row_load(tabu, __builtin_amdgcn_readfirstlane(so[b]) & 16383, lane); }
#pragma unroll 1
    for (int r = 0; r < 8; ++r) {
        LAS int* SO = PEER_SO(r);
        const int t = tokw + r; const GAS float* hr = hrow + (size_t)t * D;
        const float mu1 = st[2 * t] * (1.0f / D), rs1 = 1.0f / sqrtf(st[2 * t + 1] * (1.0f / D) - mu1 * mu1 + NORM_EPS);
#define LNH(q, ln) ((*(const GAS f32x4*)(hr + 256 * (q) + 4 * (ln)) - mu1) * rs1 * *(const LAS f32x4*)(F.lds + (q) * PEER_WLDS + PEER_G1OFF + 16 * (ln)) + *(const LAS f32x4*)(F.lds + (q) * PEER_WLDS + PEER_B1OFF + 16 * (ln)))
        f32x2 hv[16];
        { { float hh[32]; const int lnh = lane_id_opaque();
#pragma unroll
            for (int q = 0; q < 8; ++q) { const f32x4 a = LNH(q, lnh); hh[4 * q] = a[0]; hh[4 * q + 1] = a[1]; hh[4 * q + 2] = a[2]; hh[4 * q + 3] = a[3]; }
#pragma unroll
            for (int i = 0; i < 16; ++i) hv[i] = (f32x2){hh[fp6_map(2 * i)], hh[fp6_map(2 * i + 1)]}; }
#pragma unroll 1
          for (int base = 0; base < 128; base += PEER_NB) {
              float part[PEER_NB];
#pragma unroll
              for (int b = 0; b < PEER_NB; ++b) {
                  __builtin_amdgcn_s_setprio(2);
                  const f32x32 f = row_unpack(bu[b % PEER_RDEP]);
                  { const int nx = base + PEER_RDEP + b;
                    if (nx < 128) bu[b % PEER_RDEP] = row_load(tabu, __builtin_amdgcn_readfirstlane(SO[nx]) & 16383, lane);
                    else bu[b % PEER_RDEP] = row_load(tabv, __builtin_amdgcn_readfirstlane(SO[nx - 128]) & 16383, lane); }
                  __builtin_amdgcn_s_setprio(0);
                  f32x2 a0 = {0.f, 0.f}, a1 = {0.f, 0.f}, a2 = {0.f, 0.f}, a3 = {0.f, 0.f};
#pragma unroll
                  for (int i = 0; i < 16; i += 4) { a0 += (f32x2){f[2 * i], f[2 * i + 1]} * hv[i]; a1 += (f32x2){f[2 * i + 2], f[2 * i + 3]} * hv[i + 1];
                      a2 += (f32x2){f[2 * i + 4], f[2 * i + 5]} * hv[i + 2]; a3 += (f32x2){f[2 * i + 6], f[2 * i + 7]} * hv[i + 3]; }
                  a0 = (a0 + a1) + (a2 + a3);
                  part[b] = a0.x + a0.y;
#ifdef PEER_PIN
                  asm volatile("" ::: "memory");
#endif
              }
              const bool h5 = lane & 32, h4 = lane & 16, h3 = lane & 8; const int pidx = 4 * ((lane >> 3) & 1) + 2 * ((lane >> 4) & 1) + (lane >> 5);
#pragma unroll
              for (int g = 0; g < PEER_NB; g += 8) {
                  float r4[4], r2[2];
#pragma unroll
                  for (int i = 0; i < 4; ++i) { const float x = h5 ? part[g + 2 * i] : part[g + 2 * i + 1], y = h5 ? part[g + 2 * i + 1] : part[g + 2 * i]; r4[i] = y + __shfl_xor(x, 32); }
#pragma unroll
                  for (int i = 0; i < 2; ++i) { const float x = h4 ? r4[2 * i] : r4[2 * i + 1], y = h4 ? r4[2 * i + 1] : r4[2 * i]; r2[i] = y + __shfl_xor(x, 16); }
                  float tt; { const float x = h3 ? r2[0] : r2[1], y = h3 ? r2[1] : r2[0]; tt = y + __shfl_xor(x, 8); }
                  tt += __shfl_xor(tt, 4); tt += __shfl_xor(tt, 2); tt += __shfl_xor(tt, 1);
                  const int mm = SO[base + g + pidx];
                  if ((lane & 7) == 0) AV[mm >> 14] = tt * (1.0f / U_SCALE); } } }
        LDS_WAIT(); asm volatile("" ::: "memory");
#pragma unroll
        for (int q = 0; q < 2; ++q) { const int k = lane + 64 * q; CV[k] = GT[r * 128 + k] * gelu_erf(AV[k]) * (1.0f / V_SCALE); }
        LDS_WAIT(); asm volatile("" ::: "memory");
        if (r + 1 < 8) PEER_SORT(r + 1);
        f32x2 o[16];
#pragma unroll
        for (int k = 0; k < 16; ++k) o[k] = (f32x2){0.f, 0.f};
        { LAS int* SN = PEER_SO(r + 1);
#pragma unroll 1
          for (int base = 0; base < 128; base += PEER_NB) {
#pragma unroll
              for (int b = 0; b < PEER_NB; ++b) {
                  const float cf = CV[(SO[base + b] >> 14) & 127];
                  __builtin_amdgcn_s_setprio(2);
                  const f32x32 f = row_unpack(bu[b % PEER_RDEP]);
                  { const int nx = base + PEER_RDEP + b;
                    if (nx < 128) bu[b % PEER_RDEP] = row_load(tabv, __builtin_amdgcn_readfirstlane(SO[nx]) & 16383, lane);
                    else bu[b % PEER_RDEP] = row_load(tabu, __builtin_amdgcn_readfirstlane(SN[nx - 128]) & 16383, lane); }
                  __builtin_amdgcn_s_setprio(0);
#pragma unroll
                  for (int i = 0; i < 16; ++i) { const f32x2 v = {f[2 * i], f[2 * i + 1]}; o[i] += cf * v; }
#ifdef PEER_PIN
                  asm volatile("" ::: "memory");
#endif
              } } }
        { float y[32];
#pragma unroll
          for (int i = 0; i < 16; ++i) { y[fp6_map(2 * i)] = o[i].x + DN_ALPHA * hv[i].x; y[fp6_map(2 * i + 1)] = o[i].y + DN_ALPHA * hv[i].y; }
          float s = 0.f; const int ln2 = lane_id_opaque();
#pragma unroll
          for (int k = 0; k < 32; ++k) s += y[k];
          const float mean = wave_sum(s) * (1.0f / D); float s2 = 0.f;
#pragma unroll
          for (int k = 0; k < 32; ++k) { y[k] -= mean; s2 += y[k] * y[k]; }
          const float rstd = 1.0f / sqrtf(wave_sum(s2) * (1.0f / D) + NORM_EPS);
#pragma unroll
          for (int q = 0; q < 8; ++q) { const int c = 256 * q + 4 * ln2; const f32x4 gg = *(const LAS f32x4*)(F.lds + q * PEER_WLDS + PEER_G2OFF + 16 * ln2), bb = *(const LAS f32x4*)(F.lds + q * PEER_WLDS + PEER_B2OFF + 16 * ln2);
              const f32x4 rr = (f32x4){y[4 * q], y[4 * q + 1], y[4 * q + 2], y[4 * q + 3]} * rstd * gg + bb;
              NTST((GAS f32x4*)(xout + (size_t)t * D + c), rr);
              if (xbout) NTST((GAS u32x2*)(xbout + (size_t)t * D + c), ((u32x2){pk2(rr[0], rr[1]), pk2(rr[2], rr[3])}));
              if (q & 1) asm volatile("" ::: "memory"); } }
    }
    __syncthreads();
#undef PEER_SO
#undef PEER_SORT
}
#undef LNH
#ifndef DUPMASK
#define DUPMASK 0
#endif
#ifndef CSEL
#define CSEL 7
#endif
#ifndef PHMASK
#define PHMASK 1023
#endif
constexpr int NPH = 1 + 9 * DEPTH;
__global__ void __launch_bounds__(NWAVES * 64, 2) mega_fwd(Args args) {
    extern __shared__ __attribute__((aligned(16))) unsigned char lds_raw[];
    Frame F;
    F.lds = (LAS unsigned char*)lds_raw;
    F.wave = __builtin_amdgcn_readfirstlane(threadIdx.x >> 6); F.lane = lane_id_opaque(); F.tid = F.wave * 64 + F.lane;
#define RELANE() do { F.lane = lane_id_opaque(); F.tid = F.wave * 64 + F.lane; } while (0)
    F.G = gridDim.x; { const int bx = blockIdx.x; F.vcu = (F.G % 8 == 0) ? (bx % 8) * (F.G / 8) + bx / 8 : bx; }
    F.ws = (GAS unsigned char*)args.ws;
    unsigned* ctl = (unsigned*)(args.ws + WS_CTL);
    for (int u = threadIdx.x; u < (LDS_BYTES - LDSCTL_OFF) / 4; u += NWAVES * 64) ((LAS unsigned*)(F.lds + LDSCTL_OFF))[u] = 0u;
    __syncthreads();
    XcdBarrier bar; bar.bar = ctl + CW_BAR; bar.x = 0; bar.st = nullptr; bar.wave = F.wave;
#if !MK_PER_PHASE
    bar = xcd_barrier_post(ctl + CW_BAR, (volatile LAS unsigned*)(F.lds + MISC_OFF) + 8, F.wave);
#endif
    const int lo = args.ph_lo, hi = args.ph_hi;
#define IN(k) (lo <= (k) && (k) < hi)
#if MK_PER_PHASE
#define SEAM(k) do { } while (0)
#else
#define SEAM(k) do { if (IN(k) && IN((k) + 1)) xcd_barrier(bar); } while (0)
#endif
    const int bid = (int)blockIdx.x, G = F.G;

#ifdef BENCH
    { f32x32 bo; u32x6 bi = {1u, 2u, 3u, 4u, 5u, 6u}; u32x16 bo16; f32x2 p0 = {1.f, 2.f}, p1 = {0.5f, 0.25f}, p2 = {0.f, 0.f}; float q0 = 1.f, q1 = 0.5f, q2 = 0.f; unsigned w0 = 0x3f803f80u, w1 = 0x3f003f00u; int i0 = 0x01020304, i1 = 0x04030201, i2 = 0; unsigned ub = 0x80402010u;
      asm volatile("" : "+v"(bi), "+v"(p0), "+v"(p1), "+v"(q0), "+v"(q1), "+v"(w0), "+v"(w1), "+v"(i0), "+v"(i1), "+v"(ub));
#pragma unroll 1
      for (int it = 0; it < BENCH_N; ++it) {
#define R16(x) x x x x x x x x x x x x x x x x
#if BENCH == 1
          R16(asm volatile("v_cvt_scalef32_pk32_f32_fp6 %0, %1, 1.0" : "=v"(bo) : "v"(bi));)
#elif BENCH == 2
          R16(asm volatile("v_cvt_scalef32_pk32_bf16_fp6 %0, %1, 1.0" : "=v"(bo16) : "v"(bi));)
#elif BENCH == 3
          R16(asm volatile("v_pk_fma_f32 %0, %1, %2, %0" : "+v"(p2) : "v"(p0), "v"(p1));)
#elif BENCH == 4
          R16(asm volatile("v_fma_f32 %0, %1, %2, %0" : "+v"(q2) : "v"(q0), "v"(q1));)
#elif BENCH == 5
          R16(asm volatile("v_dot2c_f32_bf16 %0, %1, %2" : "+v"(q2) : "v"(w0), "v"(w1));)
#elif BENCH == 6
          R16(asm volatile("v_dot4_i32_i8 %0, %1, %2, %0" : "+v"(i2) : "v"(i0), "v"(i1));)
#elif BENCH == 7
          R16(asm volatile("v_cvt_f32_ubyte1 %0, %1" : "=v"(q2) : "v"(ub));)
#elif BENCH == 8
          R16(asm volatile("v_cvt_pk_f32_fp8 %0, %1" : "=v"(p2) : "v"(ub));)
#elif BENCH == 9
          { f32x2 z[16]; for (int i_ = 0; i_ < 16; ++i_) asm volatile("v_pk_fma_f32 %0, %1, %2, %1" : "=v"(z[i_]) : "v"(p0), "v"(p1)); for (int i_ = 0; i_ < 16; ++i_) asm volatile("" :: "v"(z[i_])); }
#elif BENCH == 10
          { float z[16]; for (int i_ = 0; i_ < 16; ++i_) asm volatile("v_fma_f32 %0, %1, %2, %1" : "=v"(z[i_]) : "v"(q0), "v"(q1)); for (int i_ = 0; i_ < 16; ++i_) asm volatile("" :: "v"(z[i_])); }
#endif
      }
      asm volatile("" :: "v"(bo), "v"(bo16), "v"(p2), "v"(q2), "v"(i2)); }
#endif
    if (((PHMASK >> 0) & 1) && IN(0)) for (int rep_ = 0; rep_ < ((((DUPMASK) >> 0) & 1) ? 2 : 1); ++rep_) { RELANE(); p0_prologue(F, args); }
    SEAM(0);
#pragma unroll 1
    for (int l = 0; l < DEPTH; ++l) {
        const int pb = 1 + 9 * l;
        GAS unsigned char* ws = (GAS unsigned char*)args.ws; asm volatile("" : "+s"(ws));
        GAS bf16* XB = (GAS bf16*)(ws + WS_XB); GAS float* XA = (GAS float*)(ws + WS_XA);
        GAS bf16* GATES = (GAS bf16*)(ws + WS_R1); GAS float* Y = (GAS float*)(ws + WS_R1); GAS bf16* SC = (GAS bf16*)(ws + WS_R1 + (size_t)T * D * 4);
        GAS bf16* HM = (GAS bf16*)(ws + WS_HM); GAS bf16* BR = (GAS bf16*)(ws + WS_BR); GAS bf16* PY = (GAS bf16*)(ws + WS_PY); GAS bf16* KPE = (GAS bf16*)(ws + WS_KPE); GAS float* RS = (GAS float*)(ws + WS_RS);
        GAS bf16* Q = (GAS bf16*)(ws + WS_Q); GAS bf16* KN = (GAS bf16*)(ws + WS_KN); GAS bf16* VT = (GAS bf16*)(ws + WS_VT);
        GAS bf16* MG = (GAS bf16*)(ws + WS_MG); GAS bf16* YB = (GAS bf16*)(ws + WS_HB); GAS float* ST = (GAS float*)(ws + WS_ST);
        const GAS float* CSl = (const GAS float*)(ws + WS_CTL) + CW_CS + l * 2048; const GAS float* BWl = (const GAS float*)(ws + WS_CTL) + CW_BW + l * 2048;
        const GAS float* cosb = (const GAS float*)(ws + WS_ROPE); const GAS float* sinb = cosb + SEQ * 32;
        if (((PHMASK >> 1) & 1) && IN(pb + 0)) for (int rep_ = 0; rep_ < ((((DUPMASK) >> 1) & 1) ? 2 : 1); ++rep_) {
            pg8::Gemm g{XB, (const GAS bf16*)(ws + WS_WIN + l * SZ_WIN), D, D, D}; pg8::StaticOrder S; S.init(T, N1, G, bid);
            pg8::EpiGemm1 E{GATES, HM};
            pg8::gemm_phase(F.lds, F.wave, g, S, E);
        }
        SEAM(pb + 0);
        if (((PHMASK >> 2) & 1) && IN(pb + 1)) for (int rep_ = 0; rep_ < ((((DUPMASK) >> 2) & 1) ? 2 : 1); ++rep_) {
            RELANE();
            for (int u = F.vcu; u < 256; u += G) swa_unit(F, u, HM, BR, ((const GAS float*)args.in[3]) + l * 8);
            for (int ch = F.vcu; ch < 256; ch += G) elem_chunk(F, ch, HM, BR, PY, KPE, RS, ST, ((const GAS float*)args.in[2]) + l * 3 * 512, cosb, sinb);
        }
        SEAM(pb + 1);
        if (((PHMASK >> 3) & 1) && IN(pb + 2)) for (int rep_ = 0; rep_ < ((((DUPMASK) >> 3) & 1) ? 2 : 1); ++rep_) {
            if (CSEL & 1) { pg8::Gemm g{HM + C_CQ, (const GAS bf16*)(ws + WS_WQUP + l * SZ_WQUP), 512, HM_LD, 512}; pg8::StaticOrder S; S.init(T, 768, G, bid);
              pg8::EpiQ E{Q, RS, cosb, sinb}; pg8::gemm_phase(F.lds, F.wave, g, S, E); }
            if (CSEL & 2) { pg8::Gemm g{HM + C_CKV, (const GAS bf16*)(ws + WS_WKVUP + l * SZ_WKVUP), 256, HM_LD, 256}; pg8::StaticOrder S; S.init(T, 1024, G, bid);
              pg8::EpiKV E{KN, VT, RS}; pg8::gemm_phase(F.lds, F.wave, g, S, E); }
            if (CSEL & 4) { pg8::Gemm g{PY, (const GAS bf16*)(ws + WS_WPOOL + l * SZ_WPOOL), 512, 512, 512}; pg8::StaticOrder S; S.init(T, 512, G, (bid + 64) % G);
              pg8::EpiPool E{BR, ((const GAS float*)args.in[9]) + l * 512}; pg8::gemm_phase(F.lds, F.wave, g, S, E); }
        }
        SEAM(pb + 2);
        if (((PHMASK >> 4) & 1) && IN(pb + 3)) for (int rep_ = 0; rep_ < ((((DUPMASK) >> 4) & 1) ? 2 : 1); ++rep_) { RELANE(); mla_phase(F, Q, KN, KPE, VT, BR); }
        SEAM(pb + 3);
        if (((PHMASK >> 5) & 1) && IN(pb + 4)) for (int rep_ = 0; rep_ < ((((DUPMASK) >> 5) & 1) ? 2 : 1); ++rep_) {
            pg8::Gemm g{BR, (const GAS bf16*)(ws + WS_WBR + l * SZ_WBR), 512, D, 512}; pg8::MergeOrder S{G, bid};
            pg8::EpiMerge E{GATES, MG};
            pg8::gemm_phase(F.lds, F.wave, g, S, E);
        }
        SEAM(pb + 4);
        if (((PHMASK >> 6) & 1) && IN(pb + 5)) for (int rep_ = 0; rep_ < ((((DUPMASK) >> 6) & 1) ? 2 : 1); ++rep_) {
            pg8::Gemm g{MG, (const GAS bf16*)(ws + WS_WOUT + l * SZ_WSQ), D, D, D}; pg8::StaticOrder S; S.init(T, D, G, bid);
            pg8::EpiOut E{l == 0 ? ((const GAS float*)args.in[0]) : XA, Y, YB, ST};
            pg8::gemm_phase(F.lds, F.wave, g, S, E);
        }
        SEAM(pb + 5);
        if (((PHMASK >> 8) & 1) && IN(pb + 7)) for (int rep_ = 0; rep_ < ((((DUPMASK) >> 8) & 1) ? 2 : 1); ++rep_) {
            pg8::Gemm g{YB, (const GAS bf16*)(ws + WS_WPQ + l * SZ_WSQ), D, D, D}; pg8::StaticOrder S; S.init(T, D, G, bid);
            pg8::EpiScore E{SC, ST, CSl, BWl};
            pg8::gemm_phase(F.lds, F.wave, g, S, E);
        }
        SEAM(pb + 7);
        if (((PHMASK >> 9) & 1) && IN(pb + 8)) for (int rep_ = 0; rep_ < ((((DUPMASK) >> 9) & 1) ? 2 : 1); ++rep_) {
            RELANE(); const bool lastl = (l == DEPTH - 1);
#ifdef DBG_HALFPEER
            if ((((int)blockIdx.x >> 3) & 1) == 0)
            for (int ch = ((int)blockIdx.x & 7) * 16 + ((int)blockIdx.x >> 4); ch < T / 64; ch += G / 2)
#else
            for (int ch = F.vcu; ch < T / 64; ch += G)
#endif
                peer_wg(F, bar, l, ch, SC, YB, Y, ST, ((const GAS float*)args.in[12]) + l * D, ((const GAS float*)args.in[13]) + l * D, (const GAS unsigned char*)(ws + WS_TABU + l * SZ_TAB), (const GAS unsigned char*)(ws + WS_TABV + l * SZ_TAB), ((const GAS float*)args.in[18]) + l * D, ((const GAS float*)args.in[19]) + l * D,
                           lastl ? (GAS float*)args.out : XA, lastl ? (GAS bf16*)nullptr : XB);
        }
        if (l + 1 < DEPTH) SEAM(pb + 8);
    }
#undef IN
#undef SEAM
}

extern "C" void kernel_launch(void* const* d_in, const int* in_sizes, int n_in, void* d_out, int out_size, void* d_ws, size_t ws_size, hipStream_t stream) {
    static int grid = 0;
    if (grid == 0) {
        if (n_in != 20 || out_size != T * D || ws_size < WS_END) { fprintf(stderr, "kernel_launch: unexpected shapes (n_in %d, out %d, ws %zu need %zu)\n", n_in, out_size, ws_size, (size_t)WS_END); grid = -1; return; }
        int dev = 0, cus = 0, per_cu = 0;
        if (hipGetDevice(&dev) != hipSuccess || hipDeviceGetAttribute(&cus, hipDeviceAttributeMultiprocessorCount, dev) != hipSuccess) { grid = -1; return; }
        if (hipFuncSetAttribute((const void*)mega_fwd, hipFuncAttributeMaxDynamicSharedMemorySize, LDS_BYTES) != hipSuccess) { fprintf(stderr, "kernel_launch: hipFuncSetAttribute failed\n"); grid = -1; return; }
        if (hipOccupancyMaxActiveBlocksPerMultiprocessor(&per_cu, (const void*)mega_fwd, NWAVES * 64, LDS_BYTES) != hipSuccess || per_cu < 1) { fprintf(stderr, "kernel_launch: occupancy query says %d\n", per_cu); }
        (void)hipGetLastError();
        grid = cus;
    }
    if (grid < 0) return;
    if (hipMemsetAsync((char*)d_ws + WS_CTL, 0, CTL_ZERO_BYTES, stream) != hipSuccess) return;
    Args a{};
    for (int i = 0; i < 20; ++i) a.in[i] = (const float*)d_in[i];
    a.out = (float*)d_out; a.ws = (unsigned char*)d_ws;
#if MK_PER_PHASE
    for (int p = 0; p < NPH; ++p) { a.ph_lo = p; a.ph_hi = p + 1; hipLaunchKernelGGL(mega_fwd, dim3(grid), dim3(NWAVES * 64), LDS_BYTES, stream, a); }
#else
    a.ph_lo = 0; a.ph_hi = NPH;
    hipLaunchKernelGGL(mega_fwd, dim3(grid), dim3(NWAVES * 64), LDS_BYTES, stream, a);
#endif
}
```

```cpp
#define MK_PER_PHASE 0
#define PEER_PIN 1
#include <hip/hip_runtime.h>
#include <cstdio>
#include <cstdint>
#include <cmath>

#ifndef MK_PER_PHASE
#define MK_PER_PHASE 0
#endif

#define DI __device__ __forceinline__
#define LAS __attribute__((address_space(3)))
#define GAS __attribute__((address_space(1)))
typedef unsigned short bf16;
typedef short bf16x8 __attribute__((ext_vector_type(8)));
typedef short s16x4 __attribute__((ext_vector_type(4)));
typedef float f32x4 __attribute__((ext_vector_type(4)));
typedef float f32x2 __attribute__((ext_vector_type(2)));
typedef float f32x16 __attribute__((ext_vector_type(16)));
typedef float f32x32 __attribute__((ext_vector_type(32)));
typedef unsigned u32x6 __attribute__((ext_vector_type(6)));
typedef unsigned u32x16 __attribute__((ext_vector_type(16)));
typedef unsigned u32x4 __attribute__((ext_vector_type(4)));
typedef unsigned u32x2 __attribute__((ext_vector_type(2)));
typedef __bf16 bf16x2_t __attribute__((ext_vector_type(2)));
typedef __bf16 bf16x8_t __attribute__((ext_vector_type(8)));

constexpr int D = 2048, BATCH = 4, SEQ = 4096, T = BATCH * SEQ, DEPTH = 4;
constexpr int NGATE = 4 * D;
constexpr int NHM = 3648, HM_LD = 3840;
constexpr int N1 = NGATE + HM_LD;
constexpr int IN_DIM = 11840;
constexpr int C_CONVU = 0, C_CONVB = 512, C_CONVC = 1024, C_SWAQ = 1536, C_SWAK = 2048, C_SWAV = 2176, C_CQ = 2304, C_CKV = 2816, C_KR = 3072, C_POOL = 3136;
constexpr float DN_ALPHA = 1.681792830507429f;
constexpr float NORM_EPS = 1e-5f;
constexpr float LOG2E = 1.4426950408889634f;
constexpr int NEXP = 16384;

constexpr size_t MiB = 1u << 20;
constexpr size_t WS_CTL = 0, CTL_ZERO_BYTES = 1 * MiB;
constexpr size_t WS_WIN = 1 * MiB;
constexpr size_t SZ_WIN = (size_t)N1 * D * 2;
constexpr size_t WS_WQUP = WS_WIN + 4 * SZ_WIN;
constexpr size_t SZ_WQUP = 768 * 512 * 2;
constexpr size_t WS_WKVUP = WS_WQUP + 4 * SZ_WQUP;
constexpr size_t SZ_WKVUP = 1024 * 256 * 2;
constexpr size_t WS_WPOOL = WS_WKVUP + 4 * SZ_WKVUP;
constexpr size_t SZ_WPOOL = 512 * 512 * 2;
constexpr size_t WS_WBR = WS_WPOOL + 4 * SZ_WPOOL;
constexpr size_t SZ_WBR = (size_t)4 * D * 512 * 2;
constexpr size_t WS_WOUT = WS_WBR + 4 * SZ_WBR;
constexpr size_t SZ_WSQ = (size_t)D * D * 2;
constexpr size_t WS_WPQ = WS_WOUT + 4 * SZ_WSQ;
constexpr size_t WS_TABU = WS_WPQ + 4 * SZ_WSQ;
constexpr int ROWB = 1536;
constexpr size_t SZ_TAB = (size_t)NEXP * ROWB;
constexpr float U_SCALE = 80.f, V_SCALE = 48.f;
#ifndef FP6_INTERLEAVED
#define FP6_INTERLEAVED 1
#endif
DI constexpr int fp6_map(int j) { return FP6_INTERLEAVED ? (j >> 1) + 16 * (j & 1) : j; }
constexpr size_t WS_TABV = WS_TABU + 4 * SZ_TAB;
constexpr size_t WS_ROPE = WS_TABV + 4 * SZ_TAB;
constexpr size_t WS_XA = WS_ROPE + 1 * MiB;
constexpr size_t WS_XB = WS_XA + (size_t)T * D * 4;
constexpr size_t WS_R1 = WS_XB + (size_t)T * D * 2;
constexpr size_t WS_HM = WS_R1 + (size_t)T * NGATE * 2;
constexpr size_t WS_BR = WS_HM + (size_t)T * HM_LD * 2;
constexpr size_t WS_PY = WS_BR + (size_t)T * D * 2;
constexpr size_t WS_KPE = WS_PY + (size_t)T * 512 * 2;
constexpr size_t WS_RS = WS_KPE + (size_t)T * 64 * 2;
constexpr size_t WS_Q = WS_RS + 1 * MiB;
constexpr size_t WS_KN = WS_Q + (size_t)T * 768 * 2;
constexpr size_t WS_VT = WS_KN + (size_t)T * 512 * 2;
constexpr size_t WS_SLAB = WS_VT + (size_t)T * 512 * 2;
constexpr size_t WS_ST = WS_SLAB;
constexpr size_t WS_MG = WS_SLAB + (size_t)256 * 65536 * 4;
constexpr size_t WS_HB = WS_MG + (size_t)T * D * 2;
constexpr size_t WS_END = WS_HB + (size_t)T * D * 2;
static_assert(WS_END <= (size_t)2047 * MiB, "workspace map");

constexpr int CW_TMO = 0;
constexpr int CW_BAR = 4096;
constexpr int CW_CS = 65536, CW_BW = CW_CS + 4 * 2048;

constexpr int RING_BYTES = 131072;
constexpr int LDSCTL_OFF = RING_BYTES, MISC_OFF = LDSCTL_OFF + 320;
constexpr int LDS_BYTES = 147456;
constexpr int NWAVES = 8;

DI unsigned pk2(float lo, float hi) { f32x2 v = {lo, hi}; bf16x2_t b = __builtin_convertvector(v, bf16x2_t); return __builtin_bit_cast(unsigned, b); }
DI float bflo(unsigned u) { return __uint_as_float(u << 16); }
DI float bfhi(unsigned u) { return __uint_as_float(u & 0xffff0000u); }
DI float bf2f(bf16 b) { return __uint_as_float(((unsigned)b) << 16); }
DI bf16 f2bf(float f) { return (bf16)(pk2(f, 0.f) & 0xffffu); }
DI float wave_sum(float v) {
#pragma unroll
    for (int o = 1; o < 64; o <<= 1) v += __shfl_xor(v, o);
    return v;
}
DI float fast_exp2(float x) { return __builtin_amdgcn_exp2f(x); }
DI float fast_rcp(float x) { return __builtin_amdgcn_rcpf(x); }
#define LDS_WAIT() asm volatile("s_waitcnt lgkmcnt(0)" ::: "memory")
#define VM_WAIT() asm volatile("s_waitcnt vmcnt(0)" ::: "memory")
#define MFMA32(a, b, c) __builtin_amdgcn_mfma_f32_32x32x16_bf16((a), (b), (c), 0, 0, 0)
DI int crow(int reg, int h) { return (reg & 3) + 8 * (reg >> 2) + 4 * h; }
DI f32x4 ld4bf_lo(u32x4 w) { return (f32x4){bflo(w.x), bfhi(w.x), bflo(w.y), bfhi(w.y)}; }
DI f32x4 ld4bf_hi(u32x4 w) { return (f32x4){bflo(w.z), bfhi(w.z), bflo(w.w), bfhi(w.w)}; }
DI int lane_id_opaque() { int l; asm volatile("v_mbcnt_lo_u32_b32 %0, -1, 0\n\tv_mbcnt_hi_u32_b32 %0, -1, %0" : "=&v"(l)); return l; }
DI f32x16 zero16() { float z = 0.f; asm volatile("" : "+v"(z)); f32x16 r; for (int i = 0; i < 16; ++i) r[i] = z; return r; }
DI bf16x2_t cvt2(float lo, float hi) { f32x2 v = {lo, hi}; return __builtin_convertvector(v, bf16x2_t); }
namespace pg8 {
constexpr int BM = 256, BK = 64, HALF = 128, HTB = HALF * BK * 2, STAGE_BYTES = 8 * HTB, NXCD = 8, WGM = 8;
__host__ __device__ __forceinline__ int lds_byte(int r, int c) { const int st = (r >> 4) * 2 + (c >> 5), rr = r & 15, cc = c & 31, ob = rr * 64 + cc * 2; return st * 1024 + (ob ^ (((ob >> 9) & 1) << 5)); }
__host__ __device__ __forceinline__ void stage_rc(int b, int& R, int& C) { const int st = b / 1024, sb = b % 1024, swz = sb ^ (((sb >> 9) & 1) << 5); R = (st >> 1) * 16 + swz / 64; C = (st & 1) * 32 + (swz % 64) / 2; }
__host__ __device__ __forceinline__ int perm32(int rho) { const int n = rho >> 4, i = rho & 15; return 8 * (i >> 2) + 4 * n + (i & 3); }

struct Unit { int pm, pn, aoff; };
struct Gemm { const GAS bf16* A; const GAS bf16* Bt; int K, lda, ldb; };

__device__ __forceinline__ void tile_of(int L, int nM, int nN, int& pm, int& pn) {
    const int nwg = nM * nN; int wgid = L;
    { const int q = nwg / NXCD, r = nwg % NXCD, xcd = wgid % NXCD, off = wgid / NXCD; wgid = (xcd < r ? xcd * (q + 1) : r * (q + 1) + (xcd - r) * q) + off; }
    const int nig = WGM * nN, gid = wgid / nig, fm = gid * WGM, gsz = (nM - fm) < WGM ? (nM - fm) : WGM;
    pm = fm + ((wgid % nig) % gsz); pn = (wgid % nig) / gsz;
}
struct StaticOrder {
    int nM, nN, nwg, G, c;
    __device__ __forceinline__ void init(int M, int N, int G_, int c_) { nM = M / BM; nN = N / BM; nwg = nM * nN; G = G_; c = c_; }
    __device__ __forceinline__ bool next(int i, Unit& u) const {
        const long L = (long)i * G + c; if (L >= nwg) return false;
        tile_of((int)L, nM, nN, u.pm, u.pn); u.aoff = 0; return true;
    }
};
struct MergeOrder {
    int G, c;
    __device__ __forceinline__ bool next(int i, Unit& u) const {
        const long L = (long)(i >> 2) * G + c; if (L >= 512) return false;
        int pm, pn; tile_of((int)L, 64, 8, pm, pn); const int br = i & 3;
        u.pm = pm; u.pn = br * 8 + pn; u.aoff = br * 1024; return true;
    }
};

template <class Epi, class Sched>
__device__ __forceinline__ void gemm_phase(LAS unsigned char* lds, int wave_s, const Gemm g, const Sched& S, const Epi& E) {
    asm volatile("" : "+s"(wave_s));
    const int lane = lane_id_opaque(), wid = wave_s, tid = wid * 64 + lane, wr = wid >> 2, wc = wid & 3, fr = lane & 15, fq = lane >> 4;
    const int K = g.K, nt = K / BK;
    unsigned voffA[2], voffB[2];
#pragma unroll
    for (int i = 0; i < 2; ++i) { int R, C; stage_rc(tid * 16 + i * 8192, R, C); const int Rb = Epi::PERM ? ((R & ~31) + perm32(R & 31)) : R;
        voffA[i] = (unsigned)(R * g.lda + C) * 2u; voffB[i] = (unsigned)(Rb * g.ldb + C) * 2u; }
    const size_t kstep = (size_t)(BK * 2);
    const size_t hstepA = (size_t)HALF * g.lda * 2, hstepB = (size_t)HALF * g.ldb * 2;
    const size_t tstepA = 2 * hstepA, tstepB = 2 * hstepB;
    const unsigned ldsw = (unsigned)wid * 1024u;
    const int aoff = lds_byte(wr * 64 + fr, fq * 8), boff = lds_byte(wc * 32 + fr, fq * 8);
#define PG8_SA(b, h) (((b) * 2 + (h)) * HTB)
#define PG8_SB(b, h) ((4 + (b) * 2 + (h)) * HTB)
#define PG8_STAGE(bufoff, gbase, voff) do { _Pragma("unroll") for (int _i = 0; _i < 2; ++_i) \
        __builtin_amdgcn_global_load_lds((const GAS unsigned*)((const GAS char*)(gbase) + (voff)[_i]), (LAS unsigned*)(lds + (bufoff) + ldsw + _i * 8192), 16, 0, 0); } while (0)
#define PG8_LDA(dst, b, h) do { _Pragma("unroll") for (int m = 0; m < 4; ++m) _Pragma("unroll") for (int k = 0; k < 2; ++k) dst[m][k] = *(const LAS bf16x8*)(lds + PG8_SA(b, h) + aoff + m * 2048 + k * 1024); } while (0)
#define PG8_LDB(dst, b, h) do { _Pragma("unroll") for (int n = 0; n < 2; ++n) _Pragma("unroll") for (int k = 0; k < 2; ++k) dst[n][k] = *(const LAS bf16x8*)(lds + PG8_SB(b, h) + boff + n * 2048 + k * 1024); } while (0)
#define PG8_MMA(ai, bj, At, Bt) do { __builtin_amdgcn_s_setprio(1); _Pragma("unroll") for (int m = 0; m < 4; ++m) _Pragma("unroll") for (int n = 0; n < 2; ++n) _Pragma("unroll") for (int k = 0; k < 2; ++k) \
        acc[ai][bj][m][n] = __builtin_amdgcn_mfma_f32_16x16x32_bf16(Bt[n][k], At[m][k], acc[ai][bj][m][n], 0, 0, 0); __builtin_amdgcn_s_setprio(0); } while (0)
#define PG8_WAIT_V(n) asm volatile("s_waitcnt vmcnt(" #n ")" ::: "memory")
#define PG8_WAIT_L(n) asm volatile("s_waitcnt lgkmcnt(" #n ")" ::: "memory")
#define PG8_BAR __builtin_amdgcn_s_barrier()
#define PG8_SCHED __builtin_amdgcn_sched_barrier(0)
    Unit cur, nxt; int ui = 0;
    if (!S.next(0, cur)) return;
    f32x4 acc[2][2][4][2];
#pragma unroll
    for (int a = 0; a < 2; ++a)
#pragma unroll
        for (int b = 0; b < 2; ++b)
#pragma unroll
            for (int m = 0; m < 4; ++m)
#pragma unroll
                for (int n = 0; n < 2; ++n) acc[a][b][m][n] = (f32x4){0.f, 0.f, 0.f, 0.f};
    bf16x8 At[4][2], B0[2][2], B1[2][2];
    const GAS char* cA = (const GAS char*)g.A + (size_t)cur.pm * tstepA + cur.aoff; const GAS char* cB = (const GAS char*)g.Bt + (size_t)cur.pn * tstepB;
    PG8_STAGE(PG8_SB(0, 0), cB, voffB); PG8_STAGE(PG8_SB(0, 1), cB + hstepB, voffB); PG8_STAGE(PG8_SA(0, 0), cA, voffA); PG8_STAGE(PG8_SA(0, 1), cA + hstepA, voffA);
    if (wr == 1) PG8_BAR;
    PG8_WAIT_V(2); PG8_BAR;
    PG8_STAGE(PG8_SB(1, 0), cB + kstep, voffB); PG8_STAGE(PG8_SA(1, 0), cA + kstep, voffA); PG8_STAGE(PG8_SB(1, 1), cB + hstepB + kstep, voffB);
    PG8_WAIT_V(6); PG8_BAR;
    for (;;) {
        const bool has_next = S.next(ui + 1, nxt);
        const GAS char* nA = has_next ? (const GAS char*)g.A + (size_t)nxt.pm * tstepA + nxt.aoff : cA; const GAS char* nB = has_next ? (const GAS char*)g.Bt + (size_t)nxt.pn * tstepB : cB;
#pragma unroll 1
        for (int t = 0; t < nt; t += 2) {
            const bool last = (t == nt - 2);
            const GAS char* a1 = cA + (size_t)(t + 1) * kstep;
            const GAS char* a2 = last ? nA : cA + (size_t)(t + 2) * kstep; const GAS char* b2 = last ? nB : cB + (size_t)(t + 2) * kstep;
            const GAS char* a3 = a2 + kstep; const GAS char* b3 = b2 + kstep;
            PG8_LDB(B0, 0, 0); PG8_LDB(B1, 0, 1); PG8_SCHED; PG8_LDA(At, 0, 0); PG8_STAGE(PG8_SA(1, 1), a1 + hstepA, voffA);
            PG8_WAIT_V(8); PG8_WAIT_L(0); PG8_BAR; PG8_MMA(0, 0, At, B0); PG8_MMA(0, 1, At, B1); PG8_BAR; PG8_SCHED;
            PG8_LDA(At, 0, 1); PG8_STAGE(PG8_SB(0, 0), b2, voffB); PG8_STAGE(PG8_SB(0, 1), b2 + hstepB, voffB); PG8_STAGE(PG8_SA(0, 0), a2, voffA);
            PG8_WAIT_V(8); PG8_WAIT_L(0); PG8_BAR; PG8_MMA(1, 0, At, B0); PG8_MMA(1, 1, At, B1); PG8_BAR; PG8_SCHED;
            PG8_LDB(B0, 1, 0); PG8_LDB(B1, 1, 1); PG8_SCHED; PG8_LDA(At, 1, 0); PG8_STAGE(PG8_SA(0, 1), a2 + hstepA, voffA);
            PG8_WAIT_V(8); PG8_WAIT_L(0); PG8_BAR; PG8_MMA(0, 0, At, B0); PG8_MMA(0, 1, At, B1); PG8_BAR; PG8_SCHED;
            PG8_LDA(At, 1, 1); PG8_STAGE(PG8_SB(1, 0), b3, voffB); PG8_STAGE(PG8_SB(1, 1), b3 + hstepB, voffB); PG8_STAGE(PG8_SA(1, 0), a3, voffA);
            PG8_WAIT_V(8); PG8_WAIT_L(0); PG8_BAR; PG8_MMA(1, 0, At, B0); PG8_MMA(1, 1, At, B1); PG8_BAR; PG8_SCHED;
        }
        if (wr == 0) PG8_BAR;
        E(acc, cur, wr, wc, fr, fq);
        if (!has_next) break;
        if constexpr (!Epi::KEEP) {
#pragma unroll
        for (int a = 0; a < 2; ++a)
#pragma unroll
            for (int b = 0; b < 2; ++b)
#pragma unroll
                for (int m = 0; m < 4; ++m)
#pragma unroll
                    for (int n = 0; n < 2; ++n) acc[a][b][m][n] = (f32x4){0.f, 0.f, 0.f, 0.f};
        }
        cur = nxt; cA = nA; cB = nB; ++ui;
        if (wr == 1) PG8_BAR;
    }
    PG8_WAIT_V(0);
    PG8_BAR;
#undef PG8_SA
#undef PG8_SB
#undef PG8_STAGE
#undef PG8_LDA
#undef PG8_LDB
#undef PG8_MMA
#undef PG8_WAIT_V
#undef PG8_WAIT_L
#undef PG8_BAR
#undef PG8_SCHED
}

typedef f32x4 AccT[2][2][4][2];

struct EpiGemm1 {
    static constexpr bool PERM = true, KEEP = false;
    GAS bf16* gates; GAS bf16* hm;
    __device__ __forceinline__ void operator()(AccT& acc, const Unit& u, int wr, int wc, int fr, int fq) const {
        int ln; { ln = lane_id_opaque(); fr = ln & 15; fq = ln >> 4; }
        const int row0 = u.pm * BM + wr * 64 + fr; const bool isg = u.pn < 32;
        if (isg) {
            const int pnE = u.pn >> 2, bjE = (u.pn >> 1) & 1, wcE = 2 * (u.pn & 1) + (wc >> 1), fqE = 2 * (wc & 1) + (fq >> 1);
            GAS bf16* tb = gates + (size_t)((u.pm * 8 + pnE) * 4) * 65536 + (fr + 16 * fqE) * 8 + 4 * (fq & 1);
#pragma unroll
            for (int ai = 0; ai < 2; ++ai)
#pragma unroll
                for (int m = 0; m < 4; ++m) { GAS bf16* rowp = tb + ((((ai * 2 + wr) * 4 + m) * 2 + bjE) * 4 + wcE) * 512; float r[4][4];
#pragma unroll
                    for (int j = 0; j < 4; ++j) { float dn[4];
#pragma unroll
                        for (int i = 0; i < 4; ++i) dn[i] = fminf(1.f + fast_exp2(-LOG2E * acc[ai][i >> 1][m][i & 1][j]), 1e4f);
#pragma unroll
                        for (int i = 0; i < 4; ++i) r[i][j] = fast_rcp(dn[i]) * (i < 3 ? dn[(i + 1) & 3] : 1.0f); }
#pragma unroll
                    for (int i = 0; i < 4; ++i) *(GAS u32x2*)(rowp + i * 65536) = (u32x2){pk2(r[i][0], r[i][1]), pk2(r[i][2], r[i][3])}; }
        } else {
            const int col0 = (u.pn - 32) * BM + wc * 32 + 8 * fq;
#pragma unroll
            for (int ai = 0; ai < 2; ++ai)
#pragma unroll
                for (int m = 0; m < 4; ++m) { GAS bf16* rowp = hm + (size_t)(row0 + ai * HALF + m * 16) * HM_LD + col0;
#pragma unroll
                    for (int bj = 0; bj < 2; ++bj) { const f32x4 v0 = acc[ai][bj][m][0], v1 = acc[ai][bj][m][1];
                        u32x4 w; w.x = pk2(v0[0], v0[1]); w.y = pk2(v0[2], v0[3]); w.z = pk2(v1[0], v1[1]); w.w = pk2(v1[2], v1[3]);
                        *(GAS u32x4*)(rowp + bj * HALF) = w; } }
        }
    }
};

struct EpiQ {
    static constexpr bool PERM = true, KEEP = false;
    GAS bf16* q; const GAS float* rs; const GAS float* cosb; const GAS float* sinb;
    __device__ __forceinline__ void operator()(AccT& acc, const Unit& u, int wr, int wc, int fr, int fq) const {
        { const int ln = lane_id_opaque(); fr = ln & 15; fq = ln >> 4; }
        const int row0 = u.pm * BM + wr * 64 + fr; const float qs = 0.07216878364870322f * LOG2E;
        float sc[2][4];
#pragma unroll
        for (int ai = 0; ai < 2; ++ai)
#pragma unroll
            for (int m = 0; m < 4; ++m) sc[ai][m] = rs[2 * (row0 + ai * HALF + m * 16)] * qs;
#pragma unroll
        for (int bj = 0; bj < 2; ++bj) { const int c0 = u.pn * BM + bj * HALF + wc * 32 + 8 * fq; const int within = c0 % 192; const bool rope = within >= 128; const int j0 = rope ? (within - 128) >> 1 : 0;
#pragma unroll
            for (int am = 0; am < 2; ++am) { f32x4 cs[4], sn[4];
                if (rope) {
#pragma unroll
                    for (int m = 0; m < 4; ++m) { const int pos = (row0 + am * HALF + m * 16) & (SEQ - 1); cs[m] = *(const GAS f32x4*)(cosb + pos * 32 + j0); sn[m] = *(const GAS f32x4*)(sinb + pos * 32 + j0); } }
#pragma unroll
                for (int m = 0; m < 4; ++m) { const int ai = am; const int row = row0 + ai * HALF + m * 16;
                    f32x4 v0 = acc[ai][bj][m][0] * sc[ai][m], v1 = acc[ai][bj][m][1] * sc[ai][m];
                    if (rope) { f32x4 o0, o1;
                        o0[0] = v0[0] * cs[m][0] - v0[1] * sn[m][0]; o0[1] = v0[1] * cs[m][0] + v0[0] * sn[m][0];
                        o0[2] = v0[2] * cs[m][1] - v0[3] * sn[m][1]; o0[3] = v0[3] * cs[m][1] + v0[2] * sn[m][1];
                        o1[0] = v1[0] * cs[m][2] - v1[1] * sn[m][2]; o1[1] = v1[1] * cs[m][2] + v1[0] * sn[m][2];
                        o1[2] = v1[2] * cs[m][3] - v1[3] * sn[m][3]; o1[3] = v1[3] * cs[m][3] + v1[2] * sn[m][3];
                        v0 = o0; v1 = o1; }
                    u32x4 w; w.x = pk2(v0[0], v0[1]); w.y = pk2(v0[2], v0[3]); w.z = pk2(v1[0], v1[1]); w.w = pk2(v1[2], v1[3]);
                    *(GAS u32x4*)(q + (size_t)row * 768 + c0) = w; } } }
    }
};

struct EpiKV {
    static constexpr bool PERM = true, KEEP = false;
    GAS bf16* kn; GAS bf16* vt; const GAS float* rs;
    __device__ __forceinline__ void operator()(AccT& acc, const Unit& u, int wr, int wc, int fr, int fq) const {
        { const int ln = lane_id_opaque(); fr = ln & 15; fq = ln >> 4; }
        const int row0 = u.pm * BM + wr * 64 + fr;
        float sc[2][4];
        { const GAS float* rp = rs + 2 * row0 + 1;
#pragma unroll
        for (int ai = 0; ai < 2; ++ai)
#pragma unroll
            for (int m = 0; m < 4; ++m) sc[ai][m] = rp[2 * (ai * HALF + m * 16)]; }
        if (u.pn < 2) {
#pragma unroll
            for (int ai = 0; ai < 2; ++ai)
#pragma unroll
                for (int m = 0; m < 4; ++m) { const int row = row0 + ai * HALF + m * 16;
#pragma unroll
                    for (int bj = 0; bj < 2; ++bj) { const f32x4 v0 = acc[ai][bj][m][0] * sc[ai][m], v1 = acc[ai][bj][m][1] * sc[ai][m]; const int c0 = u.pn * BM + bj * HALF + wc * 32 + 8 * fq;
                        u32x4 w; w.x = pk2(v0[0], v0[1]); w.y = pk2(v0[2], v0[3]); w.z = pk2(v1[0], v1[1]); w.w = pk2(v1[2], v1[3]);
                        *(GAS u32x4*)(kn + (size_t)row * 512 + c0) = w; } }
        } else {
            const int b = row0 >> 12, s0 = row0 & (SEQ - 1);
#pragma unroll
            for (int bj = 0; bj < 2; ++bj) { const int head = 2 * (u.pn - 2) + bj;
#pragma unroll
                for (int n = 0; n < 2; ++n)
#pragma unroll
                    for (int j = 0; j < 4; ++j) { const int dv = wc * 32 + 8 * fq + 4 * n + j;
                        GAS bf16* p = vt + ((size_t)((b * 4 + head) * 128 + dv)) * SEQ + s0;
#pragma unroll
                        for (int ai = 0; ai < 2; ++ai)
#pragma unroll
                            for (int m = 0; m < 4; ++m) p[ai * HALF + m * 16] = f2bf(acc[ai][bj][m][n][j] * sc[ai][m]); } }
        }
    }
};

struct EpiPool {
    static constexpr bool PERM = true, KEEP = false;
    GAS bf16* br; const GAS float* scale;
    __device__ __forceinline__ void operator()(AccT& acc, const Unit& u, int wr, int wc, int fr, int fq) const {
        { const int ln = lane_id_opaque(); fr = ln & 15; fq = ln >> 4; }
        const int row0 = u.pm * BM + wr * 64 + fr;
#pragma unroll
        for (int bj = 0; bj < 2; ++bj) { const int c0 = u.pn * BM + bj * HALF + wc * 32 + 8 * fq;
            const f32x4 s0 = *(const GAS f32x4*)(scale + c0), s1 = *(const GAS f32x4*)(scale + c0 + 4);
#pragma unroll
            for (int ai = 0; ai < 2; ++ai)
#pragma unroll
                for (int m = 0; m < 4; ++m) { const int row = row0 + ai * HALF + m * 16; const f32x4 v0 = acc[ai][bj][m][0] * s0, v1 = acc[ai][bj][m][1] * s1;
                    u32x4 w; w.x = pk2(v0[0], v0[1]); w.y = pk2(v0[2], v0[3]); w.z = pk2(v1[0], v1[1]); w.w = pk2(v1[2], v1[3]);
                    *(GAS u32x4*)(br + (size_t)row * D + 1536 + c0) = w; } }
    }
};

struct EpiMerge {
    static constexpr bool PERM = true, KEEP = true;
    const GAS bf16* gates; GAS bf16* mg;
    __device__ __forceinline__ void operator()(AccT& acc, const Unit& u, int wr, int wc, int fr, int fq) const {
        int ln; { ln = lane_id_opaque(); fr = ln & 15; fq = ln >> 4; }
        const int br = u.pn >> 3, pn = u.pn & 7; const int row0 = u.pm * BM + wr * 64 + fr; const int c0 = pn * BM + wc * 32 + 8 * fq;
        const GAS bf16* gp = gates + (size_t)((u.pm * 8 + pn) * 4 + br) * 65536 + (wr * 32 + wc) * 512 + ln * 8;
#pragma unroll
        for (int am = 0; am < 4; ++am) { const int ai = am >> 1, mh = (am & 1) * 2; u32x4 gw[2][2];
#pragma unroll
            for (int mm = 0; mm < 2; ++mm)
#pragma unroll
                for (int bj = 0; bj < 2; ++bj) gw[mm][bj] = __builtin_nontemporal_load((const GAS u32x4*)(gp + (((ai * 2) * 4 + (mh + mm)) * 2 + bj) * 4 * 512));
            if (br < 3) {
#pragma unroll
                for (int mm = 0; mm < 2; ++mm)
#pragma unroll
                    for (int bj = 0; bj < 2; ++bj) { acc[ai][bj][mh + mm][0] *= ld4bf_lo(gw[mm][bj]); acc[ai][bj][mh + mm][1] *= ld4bf_hi(gw[mm][bj]); }
            } else {
#pragma unroll
                for (int mm = 0; mm < 2; ++mm) { const int m = mh + mm; const int row = row0 + ai * HALF + m * 16;
#pragma unroll
                    for (int bj = 0; bj < 2; ++bj) { const f32x4 v0 = acc[ai][bj][m][0] * ld4bf_lo(gw[mm][bj]), v1 = acc[ai][bj][m][1] * ld4bf_hi(gw[mm][bj]);
                        u32x4 w; w.x = pk2(v0[0], v0[1]); w.y = pk2(v0[2], v0[3]); w.z = pk2(v1[0], v1[1]); w.w = pk2(v1[2], v1[3]);
                        *(GAS u32x4*)(mg + (size_t)row * D + c0 + bj * HALF) = w;
                        acc[ai][bj][m][0] = (f32x4){0.f, 0.f, 0.f, 0.f}; acc[ai][bj][m][1] = (f32x4){0.f, 0.f, 0.f, 0.f}; } }
            }
            asm volatile("" ::: "memory"); }
    }
};

struct EpiOut {
    static constexpr bool PERM = true, KEEP = false;
    const GAS float* x; GAS float* y; GAS bf16* yb; GAS float* st;
    __device__ __forceinline__ void operator()(AccT& acc, const Unit& u, int wr, int wc, int fr, int fq) const {
        { const int ln = lane_id_opaque(); fr = ln & 15; fq = ln >> 4; }
        const int row0 = u.pm * BM + wr * 64 + fr, col0 = u.pn * BM + wc * 32 + 8 * fq;
#pragma unroll
        for (int am = 0; am < 4; ++am) { const int ai = am >> 1, mh = (am & 1) * 2; f32x4 xv[2][2][2];
#pragma unroll
            for (int mm = 0; mm < 2; ++mm)
#pragma unroll
                for (int bj = 0; bj < 2; ++bj) { const size_t ro = (size_t)(row0 + ai * HALF + (mh + mm) * 16) * D + col0 + bj * HALF; xv[mm][bj][0] = *(const GAS f32x4*)(x + ro); xv[mm][bj][1] = *(const GAS f32x4*)(x + ro + 4); }
#pragma unroll
            for (int mm = 0; mm < 2; ++mm) { const int m = mh + mm; const int row = row0 + ai * HALF + m * 16; const size_t ro = (size_t)row * D + col0; float s1 = 0.f, s2 = 0.f;
#pragma unroll
                for (int bj = 0; bj < 2; ++bj) {
                    const f32x4 v0 = xv[mm][bj][0] * DN_ALPHA + acc[ai][bj][m][0], v1 = xv[mm][bj][1] * DN_ALPHA + acc[ai][bj][m][1];
                    *(GAS f32x4*)(y + ro + bj * HALF) = v0; *(GAS f32x4*)(y + ro + bj * HALF + 4) = v1;
                    *(GAS u32x4*)(yb + ro + bj * HALF) = (u32x4){pk2(v0[0], v0[1]), pk2(v0[2], v0[3]), pk2(v1[0], v1[1]), pk2(v1[2], v1[3])};
                    s1 += (v0[0] + v0[1]) + (v0[2] + v0[3]) + (v1[0] + v1[1]) + (v1[2] + v1[3]);
                    s2 += (v0[0] * v0[0] + v0[1] * v0[1]) + (v0[2] * v0[2] + v0[3] * v0[3]) + (v1[0] * v1[0] + v1[1] * v1[1]) + (v1[2] * v1[2] + v1[3] * v1[3]); }
                s1 += __shfl_xor(s1, 16); s2 += __shfl_xor(s2, 16); s1 += __shfl_xor(s1, 32); s2 += __shfl_xor(s2, 32);
                if (fq == 0) { __hip_atomic_fetch_add(st + 2 * row, s1, __ATOMIC_RELAXED, __HIP_MEMORY_SCOPE_AGENT); __hip_atomic_fetch_add(st + 2 * row + 1, s2, __ATOMIC_RELAXED, __HIP_MEMORY_SCOPE_AGENT); } }
            asm volatile("" ::: "memory"); }
    }
};

struct EpiScore {
    static constexpr bool PERM = true, KEEP = false;
    GAS bf16* c; const GAS float* st; const GAS float* cs; const GAS float* bw;
    __device__ __forceinline__ void operator()(AccT& acc, const Unit& u, int wr, int wc, int fr, int fq) const {
        { const int ln = lane_id_opaque(); fr = ln & 15; fq = ln >> 4; }
        const int row0 = u.pm * BM + wr * 64 + fr, col0 = u.pn * BM + wc * 32 + 8 * fq;
        f32x4 cv[2][2], bv[2][2];
#pragma unroll
        for (int bj = 0; bj < 2; ++bj)
#pragma unroll
            for (int n = 0; n < 2; ++n) { cv[bj][n] = *(const GAS f32x4*)(cs + col0 + bj * HALF + n * 4); bv[bj][n] = *(const GAS f32x4*)(bw + col0 + bj * HALF + n * 4); }
        float sa[2][4], sb[2][4];
#pragma unroll
        for (int ai = 0; ai < 2; ++ai)
#pragma unroll
            for (int m = 0; m < 4; ++m) { const int row = row0 + ai * HALF + m * 16; sa[ai][m] = st[2 * row]; sb[ai][m] = st[2 * row + 1]; }
#pragma unroll
        for (int ai = 0; ai < 2; ++ai)
#pragma unroll
            for (int m = 0; m < 4; ++m) { const int row = row0 + ai * HALF + m * 16; const size_t ro = (size_t)row * D + col0;
                const float mu = sa[ai][m] * (1.0f / D), var = sb[ai][m] * (1.0f / D) - mu * mu, rs = 1.0f / sqrtf(var + NORM_EPS);
#pragma unroll
                for (int bj = 0; bj < 2; ++bj) { const f32x4 v0 = (acc[ai][bj][m][0] - mu * cv[bj][0]) * rs + bv[bj][0], v1 = (acc[ai][bj][m][1] - mu * cv[bj][1]) * rs + bv[bj][1];
                    *(GAS u32x4*)(c + ro + bj * HALF) = (u32x4){pk2(v0[0], v0[1]), pk2(v0[2], v0[3]), pk2(v1[0], v1[1]), pk2(v1[2], v1[3])}; } }
    }
};
}
#define XB_TMO      128
#define XB_XCNT(j)  (256  + 64 * (j))
#define XB_XSUB(j)  (1280 + 64 * (j))
#define XB_XGEN(j)  (2304 + 64 * (j))
#define XB_TOP      3328
#define XB_TOPGEN   3392
#define XCD_BAR_WORDS 3456
#define XB_SPIN_CAP (1u << 20)

__device__ __forceinline__ unsigned xb_ld(unsigned* p)              { return __hip_atomic_load(p, __ATOMIC_RELAXED, __HIP_MEMORY_SCOPE_AGENT); }
__device__ __forceinline__ unsigned xb_add(unsigned* p, unsigned v) { return __hip_atomic_fetch_add(p, v, __ATOMIC_RELAXED, __HIP_MEMORY_SCOPE_AGENT); }
__device__ __forceinline__ unsigned xb_xcc_id() { return (unsigned)__builtin_amdgcn_s_getreg((3 << 11) | 20) & 0xFu; }
#define XB_SPIN(cond, bar) do { unsigned _sp = 0; while (cond) { __builtin_amdgcn_s_sleep(1); \
    if ((++_sp & 255u) == 0u) { if (xb_ld(&(bar)[XB_TMO])) break; if (_sp > XB_SPIN_CAP) { atomicAdd(&(bar)[XB_TMO], 1u); break; } } } } while (0)

struct XcdBarrier {
    unsigned* bar; unsigned x;
    volatile LAS unsigned* st;
    int wave;
};
#define XB_LEADER(b) ((b).wave == 0 && lane_id_opaque() == 0)
__device__ __forceinline__ XcdBarrier xcd_barrier_post(unsigned* bar, volatile LAS unsigned* st, int wave) {
    XcdBarrier b; b.bar = bar; b.x = xb_xcc_id(); b.st = st; b.wave = wave;
    if (XB_LEADER(b)) (void)xb_add(&bar[XB_XCNT(b.x)], 1u);
    return b;
}
__device__ __forceinline__ void xcd_barrier_complete(unsigned* bar, unsigned x, unsigned& nloc, unsigned& nx) {
    const unsigned G = gridDim.x * gridDim.y * gridDim.z;
    unsigned sum, cnt, mine, sp = 0u;
    for (;;) {
        sum = 0u; cnt = 0u; mine = 0u;
#pragma unroll
        for (unsigned j = 0; j < 16; ++j) { const unsigned c = xb_ld(&bar[XB_XCNT(j)]); sum += c; cnt += (c > 0u) ? 1u : 0u; mine = (j == x) ? c : mine; }
        if (sum == G) break;
        __builtin_amdgcn_s_sleep(1);
        if ((++sp & 255u) == 0u) { if (xb_ld(&bar[XB_TMO])) break; if (sp > XB_SPIN_CAP) { atomicAdd(&bar[XB_TMO], 1u); break; } }
    }
    nloc = mine > 0u ? mine : 1u; nx = cnt > 0u ? cnt : 1u;
}
__device__ __forceinline__ void xcd_barrier(const XcdBarrier& b) {
    asm volatile("s_waitcnt vmcnt(0)" ::: "memory");
    __syncthreads();
    if (XB_LEADER(b)) {
        unsigned* bar = b.bar;
        __builtin_amdgcn_s_waitcnt(0);
        unsigned nloc = b.st[0], nx = b.st[1];
        if (nloc == 0u) { xcd_barrier_complete(bar, b.x, nloc, nx); b.st[0] = nloc; b.st[1] = nx; }
        const unsigned old = xb_add(&bar[XB_XSUB(b.x)], 1u);
        const unsigned gen = old / nloc;
        if (old + 1u == (gen + 1u) * nloc) {
            __builtin_amdgcn_fence(__ATOMIC_RELEASE, "agent");
            asm volatile("s_waitcnt vmcnt(0)" ::: "memory");
            const unsigned og = xb_add(&bar[XB_TOP], 1u);
            const unsigned tg = og / nx;
            if (og + 1u == (tg + 1u) * nx) xb_add(&bar[XB_TOPGEN], 1u);
            else XB_SPIN(xb_ld(&bar[XB_TOPGEN]) == tg, bar);
            __builtin_amdgcn_fence(__ATOMIC_ACQUIRE, "agent");
            xb_add(&bar[XB_XGEN(b.x)], 1u);
            asm volatile("s_waitcnt vmcnt(0)" ::: "memory");
        } else {
            XB_SPIN(xb_ld(&bar[XB_XGEN(b.x)]) == gen, bar);
            __builtin_amdgcn_fence(__ATOMIC_ACQUIRE, "agent");
            asm volatile("s_waitcnt vmcnt(0)" ::: "memory");
        }
    }
    __syncthreads();
}

struct Args {
    const float* in[20]; float* out; unsigned char* ws; int ph_lo, ph_hi;
};
struct Frame {
    LAS unsigned char* lds;
    int tid, lane, wave, vcu, G;
    GAS unsigned char* ws;
};

template <class RowMap>
DI void transpose_item(const GAS float* W, int ldw, int k0, int n0, GAS bf16* WT, int ldk, int kdst0, const GAS float* kgain, const RowMap& rm, LAS float* scr, int lane) {
#pragma unroll
    for (int i = 0; i < 8; ++i) { const int kk = 8 * i + (lane >> 3), c4 = lane & 7; f32x4 v = *(const GAS f32x4*)(W + (size_t)(k0 + kk) * ldw + n0 + 4 * c4); if (kgain) v *= kgain[k0 + kk];
        LAS float* d = scr + kk * 33 + 4 * c4; d[0] = v[0]; d[1] = v[1]; d[2] = v[2]; d[3] = v[3]; }
    LDS_WAIT(); asm volatile("" ::: "memory");
    const int c = lane & 7;
#pragma unroll
    for (int j = 0; j < 4; ++j) { const int n = (lane >> 3) + 8 * j; const LAS float* s = scr + (8 * c) * 33 + n;
        u32x4 o; o.x = pk2(s[0 * 33], s[1 * 33]); o.y = pk2(s[2 * 33], s[3 * 33]); o.z = pk2(s[4 * 33], s[5 * 33]); o.w = pk2(s[6 * 33], s[7 * 33]);
        *(GAS u32x4*)(WT + (size_t)rm(n0 + n) * ldk + kdst0 + k0 + 8 * c) = o; }
    LDS_WAIT(); asm volatile("" ::: "memory");
}
struct RmIdent { int off; DI int operator()(int n) const { return n + off; } };
struct RmWin { DI int operator()(int n) const { if (n < NHM) return n + NGATE; const int g = n - NHM, i = g >> 11, d = g & 2047;
    return 256 * (d >> 6) + 128 * (i >> 1) + 32 * ((d & 63) >> 4) + 8 * ((d >> 2) & 3) + 4 * (i & 1) + (d & 3); } };
struct RmQup { DI int operator()(int n) const { const int h = n / 192, w = n % 192; if (w < 128) return n; const int r = w - 128; const int j = r & 31, e = r >> 5; return h * 192 + 128 + 2 * j + e; } };
struct RmKvup { DI int operator()(int n) const { const int h = n >> 8, e = (n >> 7) & 1, j = n & 127; return e * 512 + h * 128 + j; } };

DI void zero_row_bytes(GAS void* p, int nbytes, int lane) { GAS u32x4* q = (GAS u32x4*)p; for (int i = lane; i < nbytes / 16; i += 64) q[i] = (u32x4){0u, 0u, 0u, 0u}; }

DI void composite_item(const GAS float* wq, const GAS float* sk, const GAS float* g1, const GAS float* b1, GAS bf16* wpq, GAS float* cs, GAS float* bw, int hp, int dblk, int lane) {
    const int p = hp & 1, r = lane & 31, hb = lane >> 5, d0 = dblk * 32;
    f32x16 acc[4];
#pragma unroll
    for (int nb = 0; nb < 4; ++nb) acc[nb] = zero16();
#pragma unroll 2
    for (int s = 0; s < 8; ++s) {
        const GAS float* bp = wq + (size_t)(d0 + r) * D + hp * 128 + 16 * s + 8 * hb;
        const f32x4 b0 = *(const GAS f32x4*)bp, b1v = *(const GAS f32x4*)(bp + 4);
        u32x4 bwv = {pk2(b0[0], b0[1]), pk2(b0[2], b0[3]), pk2(b1v[0], b1v[1]), pk2(b1v[2], b1v[3])};
        const bf16x8 bf = __builtin_bit_cast(bf16x8, bwv);
#pragma unroll
        for (int nb = 0; nb < 4; ++nb) {
            const GAS float* ap = sk + ((size_t)p * 128 + 32 * nb + r) * 128 + 16 * s + 8 * hb;
            const f32x4 a0 = *(const GAS f32x4*)ap, a1 = *(const GAS f32x4*)(ap + 4);
            u32x4 aw = {pk2(a0[0], a0[1]), pk2(a0[2], a0[3]), pk2(a1[0], a1[1]), pk2(a1[2], a1[3])};
            acc[nb] = MFMA32(__builtin_bit_cast(bf16x8, aw), bf, acc[nb]);
        }
    }
    const float gd = g1[d0 + r], bd = b1[d0 + r];
#pragma unroll
    for (int nb = 0; nb < 4; ++nb)
#pragma unroll
        for (int i = 0; i < 16; ++i) { const int n = 32 * nb + crow(i, hb); const bf16 wb = f2bf(acc[nb][i] * gd); wpq[(size_t)(hp * 128 + n) * D + d0 + r] = wb;
            float c = bf2f(wb), b = acc[nb][i] * bd;
#pragma unroll
            for (int o = 1; o < 32; o <<= 1) { c += __shfl_xor(c, o); b += __shfl_xor(b, o); }
            if (r == 0) { __hip_atomic_fetch_add(cs + hp * 128 + n, c, __ATOMIC_RELAXED, __HIP_MEMORY_SCOPE_AGENT); __hip_atomic_fetch_add(bw + hp * 128 + n, b, __ATOMIC_RELAXED, __HIP_MEMORY_SCOPE_AGENT); } }
}

DI void p0_prologue(Frame& F, const Args& a) {
    LAS float* scr = (LAS float*)(F.lds + F.wave * 16384);
    const int gw = F.vcu * NWAVES + F.wave, NGW = F.G * NWAVES, lane = F.lane;
    unsigned GAS char* ws = F.ws;
    constexpr int I_WIN = (D / 64) * (IN_DIM / 32);
    constexpr int I_QUP = (512 / 64) * (768 / 32);
    constexpr int I_KVUP = (256 / 64) * (1024 / 32);
    constexpr int I_POOL = 4 * 2 * 4;
    constexpr int I_BR = 4 * (512 / 64) * (D / 32);
    constexpr int I_OUT = (D / 64) * (D / 32);
    constexpr int I_LAYER = I_WIN + I_QUP + I_KVUP + I_POOL + I_BR + I_OUT;
    for (int it = gw; it < DEPTH * I_LAYER; it += NGW) {
        const int l = it / I_LAYER; int r = it % I_LAYER;
        if (r < I_WIN) { const int nblk = IN_DIM / 32, kb = r / nblk, nb = r % nblk;
            transpose_item(((const GAS float*)a.in[1]) + (size_t)l * D * IN_DIM, IN_DIM, 64 * kb, 32 * nb, (GAS bf16*)(ws + WS_WIN + l * SZ_WIN), D, 0, nullptr, RmWin{}, scr, lane); continue; } r -= I_WIN;
        if (r < I_QUP) { const int nblk = 768 / 32, kb = r / nblk, nb = r % nblk;
            transpose_item(((const GAS float*)a.in[5]) + (size_t)l * 512 * 768, 768, 64 * kb, 32 * nb, (GAS bf16*)(ws + WS_WQUP + l * SZ_WQUP), 512, 0, ((const GAS float*)a.in[4]) + l * 512, RmQup{}, scr, lane); continue; } r -= I_QUP;
        if (r < I_KVUP) { const int nblk = 1024 / 32, kb = r / nblk, nb = r % nblk;
            transpose_item(((const GAS float*)a.in[7]) + (size_t)l * 256 * 1024, 1024, 64 * kb, 32 * nb, (GAS bf16*)(ws + WS_WKVUP + l * SZ_WKVUP), 256, 0, ((const GAS float*)a.in[6]) + l * 256, RmKvup{}, scr, lane); continue; } r -= I_KVUP;
        if (r < I_POOL) { const int g = r >> 3, kb = (r >> 2) & 1, nb = r & 3;
            transpose_item(((const GAS float*)a.in[8]) + ((size_t)l * 4 + g) * 128 * 128, 128, 64 * kb, 32 * nb, (GAS bf16*)(ws + WS_WPOOL + l * SZ_WPOOL), 512, g * 128, nullptr, RmIdent{g * 128}, scr, lane); continue; } r -= I_POOL;
        if (r < I_BR) { const int i = r / 512, rr = r % 512, nblk = D / 32, kb = rr / nblk, nb = rr % nblk;
            transpose_item(((const GAS float*)a.in[10]) + ((size_t)l * 4 + i) * 512 * D, D, 64 * kb, 32 * nb, (GAS bf16*)(ws + WS_WBR + l * SZ_WBR), 512, 0, nullptr, RmIdent{i * D}, scr, lane); continue; } r -= I_BR;
        { const int nblk = D / 32, kb = r / nblk, nb = r % nblk;
            transpose_item(((const GAS float*)a.in[11]) + (size_t)l * D * D, D, 64 * kb, 32 * nb, (GAS bf16*)(ws + WS_WOUT + l * SZ_WSQ), D, 0, nullptr, RmIdent{0}, scr, lane); }
    }
    for (int it = gw; it < DEPTH * (192 + 512); it += NGW) {
        const int l = it / 704, r = it % 704;
        if (r < 192) zero_row_bytes(ws + WS_WIN + l * SZ_WIN + (size_t)(IN_DIM + r) * D * 2, D * 2, lane);
        else { const int n = r - 192, g = n >> 7; GAS bf16* row = (GAS bf16*)(ws + WS_WPOOL + l * SZ_WPOOL) + (size_t)n * 512;
            for (int gb = 0; gb < 4; ++gb) if (gb != g && lane < 16) *(GAS u32x4*)(row + gb * 128 + lane * 8) = (u32x4){0u, 0u, 0u, 0u}; }
    }
    for (int it = gw; it < DEPTH * 16 * 64; it += NGW) {
        const int l = it >> 10, hp = (it >> 6) & 15, dblk = it & 63;
        composite_item(((const GAS float*)a.in[14]) + (size_t)l * D * D, ((const GAS float*)a.in[15]) + (size_t)l * 2 * 128 * 128, ((const GAS float*)a.in[12]) + l * D, ((const GAS float*)a.in[13]) + l * D,
                       (GAS bf16*)(ws + WS_WPQ + l * SZ_WSQ), (GAS float*)(ws + WS_CTL) + CW_CS + l * 2048, (GAS float*)(ws + WS_CTL) + CW_BW + l * 2048, hp, dblk, lane);
    }
    { GAS float* cosb = (GAS float*)(ws + WS_ROPE); GAS float* sinb = cosb + SEQ * 32;
      for (int i = gw * 64 + lane; i < SEQ * 32; i += NGW * 64) { const int pos = i >> 5, j = i & 31;
          const float inv = fast_exp2(-(float)j * 0.41524101186092029f);
          const float ang = (float)pos * inv; double rev = (double)ang * 0.15915494309189535; rev -= __builtin_rint(rev);
          cosb[i] = __builtin_amdgcn_cosf((float)rev); sinb[i] = __builtin_amdgcn_sinf((float)rev); } }
    { const size_t gt = (size_t)gw * 64 + lane, NT = (size_t)NGW * 64;
      { const GAS float* src = ((const GAS float*)a.in[0]); GAS bf16* dst = (GAS bf16*)(ws + WS_XB); const size_t n8 = (size_t)T * D / 8;
        for (size_t i = gt; i < n8; i += NT) { const f32x4 v0 = *(const GAS f32x4*)(src + i * 8), v1 = *(const GAS f32x4*)(src + i * 8 + 4);
            *(GAS u32x4*)(dst + i * 8) = (u32x4){pk2(v0[0], v0[1]), pk2(v0[2], v0[3]), pk2(v1[0], v1[1]), pk2(v1[2], v1[3])}; } }
#pragma unroll 1
      for (int tb = 0; tb < 2; ++tb) { const GAS float* src = (const GAS float*)a.in[16 + tb]; GAS unsigned char* dst = ws + (tb ? WS_TABV : WS_TABU); const size_t n32 = (size_t)DEPTH * NEXP * 64;
        const float scl = tb ? V_SCALE : U_SCALE;
        for (size_t i = gt; i < n32; i += NT) { const size_t row = i >> 6; const int ln = (int)(i & 63);
            f32x16 va, vb; const GAS float* sp = src + row * D + 4 * ln;
#pragma unroll
            for (int q = 0; q < 4; ++q) { const f32x4 x = __builtin_nontemporal_load((const GAS f32x4*)(sp + 256 * q)) * scl, y = __builtin_nontemporal_load((const GAS f32x4*)(sp + 256 * (q + 4))) * scl;
#pragma unroll
                for (int e = 0; e < 4; ++e) { va[4 * q + e] = x[e]; vb[4 * q + e] = y[e]; } }
            const u32x6 w = __builtin_amdgcn_cvt_scalef32_2xpk16_fp6_f32(va, vb, 1.0f);
            GAS unsigned char* rp = dst + row * ROWB;
            *(GAS u32x4*)(rp + 16 * ln) = (u32x4){w[0], w[1], w[2], w[3]}; *(GAS u32x2*)(rp + 1024 + 8 * ln) = (u32x2){w[4], w[5]}; } } }
}

DI void elem_chunk(Frame& F, int ch, const GAS bf16* hm, GAS bf16* br, GAS bf16* py, GAS bf16* kpe, GAS float* rs, GAS float* st, const GAS float* convw, const GAS float* cosb, const GAS float* sinb) {
    const int T0 = ch * 64, tid = F.tid, lane = F.lane;
    if (tid < 128) st[T0 * 2 + tid] = 0.f;
    const int t0 = T0 + 8 * F.wave, pos0 = t0 & (SEQ - 1);
    const u32x4 zz = {0u, 0u, 0u, 0u};
    { f32x4 w0[3], w1[3];
#pragma unroll
      for (int d = 0; d < 3; ++d) { w0[d] = *(const GAS f32x4*)(convw + d * 512 + 8 * lane); w1[d] = *(const GAS f32x4*)(convw + d * 512 + 8 * lane + 4); }
#pragma unroll 1
      for (int h = 0; h < 2; ++h) { const int tb = t0 + 4 * h;
          const GAS bf16* rp = hm + (size_t)(tb - 2) * HM_LD + 8 * lane;
          u32x4 uw[6], cw[6], bw[4];
#pragma unroll
          for (int k = 0; k < 6; ++k) { uw[k] = *(const GAS u32x4*)(rp + (size_t)k * HM_LD + C_CONVU); cw[k] = *(const GAS u32x4*)(rp + (size_t)k * HM_LD + C_CONVC); }
#pragma unroll
          for (int k = 0; k < 4; ++k) bw[k] = *(const GAS u32x4*)(rp + (size_t)(k + 2) * HM_LD + C_CONVB);
          f32x4 z0[6], z1[6];
#pragma unroll
          for (int k = 0; k < 6; ++k) { const bool ok = (pos0 + 4 * h - 2 + k) >= 0; const u32x4 a = ok ? uw[k] : zz, c = ok ? cw[k] : zz; z0[k] = ld4bf_lo(a) * ld4bf_lo(c); z1[k] = ld4bf_hi(a) * ld4bf_hi(c); }
#pragma unroll
          for (int k = 0; k < 4; ++k) { f32x4 y0 = w0[0] * z0[k] + w0[1] * z0[k + 1] + w0[2] * z0[k + 2], y1 = w1[0] * z1[k] + w1[1] * z1[k + 1] + w1[2] * z1[k + 2];
              y0 *= ld4bf_lo(bw[k]); y1 *= ld4bf_hi(bw[k]);
              *(GAS u32x4*)(br + (size_t)(tb + k) * D + 8 * lane) = (u32x4){pk2(y0[0], y0[1]), pk2(y0[2], y0[3]), pk2(y1[0], y1[1]), pk2(y1[2], y1[3])}; }
          asm volatile("" ::: "memory"); } }
    { const int g = lane >> 4, w = 2 << g;
#pragma unroll 1
      for (int h = 0; h < 2; ++h) { const int tb = t0 + 4 * h;
          const GAS bf16* rp = hm + (size_t)(tb - 15) * HM_LD + C_POOL + 8 * lane;
          u32x4 x[19];
#pragma unroll
          for (int k = 0; k < 19; ++k) x[k] = *(const GAS u32x4*)(rp + (size_t)k * HM_LD);
#pragma unroll
          for (int k = 0; k < 15; ++k) { const bool ok = (pos0 + 4 * h - 15 + k) >= 0; x[k] = ok ? x[k] : zz; }
#pragma unroll
          for (int jj = 0; jj < 4; ++jj) { const int pos = pos0 + 4 * h + jj; const int cnt = (pos + 1 < w) ? pos + 1 : w;
              const f32x4 u0 = ld4bf_lo(x[15 + jj]), u1 = ld4bf_hi(x[15 + jj]);
              f32x4 s0 = u0 + ld4bf_lo(x[14 + jj]), s1 = u1 + ld4bf_hi(x[14 + jj]);
              if (g >= 1) {
#pragma unroll
                  for (int d = 2; d < 4; ++d) { s0 += ld4bf_lo(x[15 + jj - d]); s1 += ld4bf_hi(x[15 + jj - d]); } }
              if (g >= 2) {
#pragma unroll
                  for (int d = 4; d < 8; ++d) { s0 += ld4bf_lo(x[15 + jj - d]); s1 += ld4bf_hi(x[15 + jj - d]); } }
              if (g >= 3) {
#pragma unroll
                  for (int d = 8; d < 16; ++d) { s0 += ld4bf_lo(x[15 + jj - d]); s1 += ld4bf_hi(x[15 + jj - d]); } }
              const float ic = 1.0f / (float)cnt; s0 = s0 * ic - u0; s1 = s1 * ic - u1;
              *(GAS u32x4*)(py + (size_t)(tb + jj) * 512 + 8 * lane) = (u32x4){pk2(s0[0], s0[1]), pk2(s0[2], s0[3]), pk2(s1[0], s1[1]), pk2(s1[2], s1[3])}; }
          asm volatile("" ::: "memory"); } }
    { u32x4 qw[8], kw[8]; float x1[8], x2[8], cc[8], ss[8];
#pragma unroll
      for (int k = 0; k < 8; ++k) { const int t = t0 + k; const GAS bf16* rp = hm + (size_t)t * HM_LD; const int pos = t & (SEQ - 1);
          qw[k] = *(const GAS u32x4*)(rp + C_CQ + 8 * lane); kw[k] = *(const GAS u32x4*)(rp + C_CKV + 8 * (lane & 31));
          x1[k] = bf2f(rp[C_KR + (lane & 31)]); x2[k] = bf2f(rp[C_KR + 32 + (lane & 31)]); cc[k] = cosb[pos * 32 + (lane & 31)]; ss[k] = sinb[pos * 32 + (lane & 31)]; }
#pragma unroll
      for (int k = 0; k < 8; ++k) { const int t = t0 + k; const f32x4 a = ld4bf_lo(qw[k]), b = ld4bf_hi(qw[k]), c = ld4bf_lo(kw[k]), d = ld4bf_hi(kw[k]);
          float sq = (a[0] * a[0] + a[1] * a[1]) + (a[2] * a[2] + a[3] * a[3]) + (b[0] * b[0] + b[1] * b[1]) + (b[2] * b[2] + b[3] * b[3]);
          float skv = (c[0] * c[0] + c[1] * c[1]) + (c[2] * c[2] + c[3] * c[3]) + (d[0] * d[0] + d[1] * d[1]) + (d[2] * d[2] + d[3] * d[3]);
          skv = (lane < 32) ? skv : 0.f;
          sq = wave_sum(sq); skv = wave_sum(skv);
          if (lane == 0) { rs[2 * t] = 1.0f / sqrtf(sq * (1.0f / 512.0f) + NORM_EPS); rs[2 * t + 1] = 1.0f / sqrtf(skv * (1.0f / 256.0f) + NORM_EPS); }
          if (lane < 32) *(GAS unsigned*)(kpe + (size_t)t * 64 + 2 * lane) = pk2(x1[k] * cc[k] - x2[k] * ss[k], x2[k] * cc[k] + x1[k] * ss[k]); } }
}

constexpr int SWA_KROW = 144, SWA_VROW = 520, SWA_VOFF = 256 * SWA_KROW;
DI void swa_unit(Frame& F, int unit, const GAS bf16* hm, GAS bf16* br, const GAS float* sinks) {
    const int kvh = unit & 1, nb = (unit >> 1) & 31, b = unit >> 6;
    const int t0 = b * SEQ + nb * 128, tid = F.tid, lane = F.lane, r = lane & 31, hb = lane >> 5;
    LAS unsigned char* lds = F.lds;
    const int g = F.wave >> 1, rh = F.wave & 1, head = kvh * 4 + g;
    bf16x8 qfa[2][4];
#pragma unroll
    for (int rbi = 0; rbi < 2; ++rbi)
#pragma unroll
        for (int s = 0; s < 4; ++s) qfa[rbi][s] = *(const GAS bf16x8*)(hm + (size_t)(t0 + 32 * (2 * rh + rbi) + r) * HM_LD + C_SWAQ + 64 * head + 16 * s + 8 * hb);
#pragma unroll
    for (int k = 0; k < 4; ++k) { const int id = tid + 512 * k, row = id >> 3, ch = id & 7; const bool ok = (nb > 0) || (row >= 128);
        u32x4 kw = {0u, 0u, 0u, 0u}, vw = kw;
        if (ok) { const GAS bf16* rp = hm + (size_t)(t0 - 128 + row) * HM_LD; kw = *(const GAS u32x4*)(rp + C_SWAK + 64 * kvh + 8 * ch); vw = *(const GAS u32x4*)(rp + C_SWAV + 64 * kvh + 8 * ch); }
        *(LAS u32x4*)(lds + row * SWA_KROW + ch * 16) = kw;
        LAS unsigned char* vp = lds + SWA_VOFF + (8 * ch) * SWA_VROW + row * 2;
        *(LAS bf16*)(vp + 0 * SWA_VROW) = (bf16)(vw.x & 0xffffu); *(LAS bf16*)(vp + 1 * SWA_VROW) = (bf16)(vw.x >> 16);
        *(LAS bf16*)(vp + 2 * SWA_VROW) = (bf16)(vw.y & 0xffffu); *(LAS bf16*)(vp + 3 * SWA_VROW) = (bf16)(vw.y >> 16);
        *(LAS bf16*)(vp + 4 * SWA_VROW) = (bf16)(vw.z & 0xffffu); *(LAS bf16*)(vp + 5 * SWA_VROW) = (bf16)(vw.z >> 16);
        *(LAS bf16*)(vp + 6 * SWA_VROW) = (bf16)(vw.w & 0xffffu); *(LAS bf16*)(vp + 7 * SWA_VROW) = (bf16)(vw.w >> 16); }
    __syncthreads();
    const float slope2 = fast_exp2(-(float)(head + 1)) * LOG2E, sink2 = sinks[head] * LOG2E, qk2 = 0.125f * LOG2E;
#pragma unroll 1
    for (int rbi = 0; rbi < 2; ++rbi) { const int rb = 2 * rh + rbi; const int qrow = t0 + 32 * rb + r;
        bf16x8 qf[4];
#pragma unroll
        for (int s = 0; s < 4; ++s) qf[s] = rbi ? qfa[1][s] : qfa[0][s];
        f32x16 S[5]; float mx = sink2;
#pragma unroll
        for (int tt = 0; tt < 5; ++tt) { const int tl = rb + tt; f32x16 acc = zero16();
#pragma unroll
            for (int s = 0; s < 4; ++s) { const bf16x8 kf = *(const LAS bf16x8*)(lds + (32 * tl + r) * SWA_KROW + (16 * s + 8 * hb) * 2); acc = MFMA32(kf, qf[s], acc); }
#pragma unroll
            for (int i = 0; i < 16; ++i) { const int kb = 32 * tl + crow(i, hb), dist = 128 + 32 * rb + r - kb; const bool ok = (dist >= 0) && (dist < 128) && ((nb > 0) || (kb >= 128));
                const float v = ok ? acc[i] * qk2 - slope2 * (float)dist : -1e30f; acc[i] = v; mx = fmaxf(mx, v); }
            S[tt] = acc; }
        mx = fmaxf(mx, __shfl_xor(mx, 32));
        float den = 0.f; bf16x8 pf[5][2];
#pragma unroll
        for (int tt = 0; tt < 5; ++tt) {
#pragma unroll
            for (int i = 0; i < 16; ++i) { const float p = fast_exp2(S[tt][i] - mx); S[tt][i] = p; den += p; }
#pragma unroll
            for (int s = 0; s < 2; ++s) { u32x4 w = {pk2(S[tt][8 * s], S[tt][8 * s + 1]), pk2(S[tt][8 * s + 2], S[tt][8 * s + 3]), pk2(S[tt][8 * s + 4], S[tt][8 * s + 5]), pk2(S[tt][8 * s + 6], S[tt][8 * s + 7])};
                pf[tt][s] = __builtin_bit_cast(bf16x8, w); } }
        den += __shfl_xor(den, 32); den += fast_exp2(sink2 - mx);
        const float inv = 1.0f / den;
        f32x16 O[2]; O[0] = zero16(); O[1] = zero16();
#pragma unroll
        for (int tt = 0; tt < 5; ++tt) { const int tl = rb + tt;
#pragma unroll
            for (int s = 0; s < 2; ++s)
#pragma unroll
                for (int dvb = 0; dvb < 2; ++dvb) { const LAS unsigned char* vp = lds + SWA_VOFF + (32 * dvb + r) * SWA_VROW + (32 * tl + 16 * s + 4 * hb) * 2;
                    const s16x4 lo = *(const LAS s16x4*)vp, hi = *(const LAS s16x4*)(vp + 16);
                    const bf16x8 vf = __builtin_shufflevector(lo, hi, 0, 1, 2, 3, 4, 5, 6, 7);
                    O[dvb] = MFMA32(vf, pf[tt][s], O[dvb]); } }
        GAS bf16* op = br + (size_t)qrow * D + 512 + 64 * head;
#pragma unroll
        for (int dvb = 0; dvb < 2; ++dvb)
#pragma unroll
            for (int ig = 0; ig < 4; ++ig) { const int dv0 = 32 * dvb + 8 * ig + 4 * hb;
#ifdef DBG_ZERO_SWA
                *(GAS u32x2*)(op + dv0) = (u32x2){0u, 0u}; }
#else
                *(GAS u32x2*)(op + dv0) = (u32x2){pk2(O[dvb][4 * ig] * inv, O[dvb][4 * ig + 1] * inv), pk2(O[dvb][4 * ig + 2] * inv, O[dvb][4 * ig + 3] * inv)}; }
#endif
    }
    __syncthreads();
}
constexpr int MLA_KROW = 400, MLA_VROW = 136, MLA_KBYTES = 64 * MLA_KROW, MLA_STG = MLA_KBYTES + 128 * MLA_VROW;
static_assert(2 * MLA_STG <= RING_BYTES, "MLA stage buffers");

DI void mla_unit(Frame& F, int b, int h, int qblk, const GAS bf16* q, const GAS bf16* kn, const GAS bf16* kpe, const GAS bf16* vt, GAS bf16* br) {
    const int tid = F.tid, lane = F.lane, r = lane & 31, hb = lane >> 5, rg = F.wave & 3, kp = F.wave >> 2;
    LAS unsigned char* lds = F.lds;
    const size_t rowb = (size_t)b * SEQ; const int q0 = qblk * 128;
    const int NS = 2 * (qblk + 1);
    const int kkey0 = tid >> 4, kc0 = tid & 15;
    const int rkey = tid >> 3, rc = tid & 7;
    const int vdv0 = tid >> 3, vc = tid & 7;
    const GAS unsigned char* knb = (const GAS unsigned char*)(kn + rowb * 512 + 128 * h);
    const GAS unsigned char* kpb = (const GAS unsigned char*)(kpe + rowb * 64);
    const GAS unsigned char* vtb = (const GAS unsigned char*)(vt + (size_t)((b * 4 + h) * 128) * SEQ);
    const unsigned knl = (unsigned)(kkey0 * 512 + 8 * kc0) * 2u, kpl = (unsigned)(rkey * 64 + 8 * rc) * 2u, vtl = (unsigned)(vdv0 * SEQ + 8 * vc) * 2u;
    u32x4 sk0A, sk1A, srA, sv0A, sv1A, sk0B, sk1B, srB, sv0B, sv1B;
#define MLA_LOAD(j, X) do { const unsigned ko = (unsigned)(64 * (j)); \
        sk0##X = *(const GAS u32x4*)(knb + (size_t)ko * 1024 + knl); sk1##X = *(const GAS u32x4*)(knb + (size_t)(ko + 32) * 1024 + knl); sr##X = *(const GAS u32x4*)(kpb + (size_t)ko * 128 + kpl); \
        sv0##X = *(const GAS u32x4*)(vtb + (size_t)ko * 2 + vtl); sv1##X = *(const GAS u32x4*)(vtb + (size_t)64 * SEQ * 2 + (size_t)ko * 2 + vtl); } while (0)
#define MLA_STORE(buf, X) do { LAS unsigned char* sb = lds + (buf) * MLA_STG; \
        *(LAS u32x4*)(sb + kkey0 * MLA_KROW + kc0 * 16) = sk0##X; *(LAS u32x4*)(sb + (kkey0 + 32) * MLA_KROW + kc0 * 16) = sk1##X; \
        *(LAS u32x4*)(sb + rkey * MLA_KROW + 256 + rc * 16) = sr##X; \
        LAS unsigned char* vb = sb + MLA_KBYTES + vdv0 * MLA_VROW + vc * 16; \
        *(LAS u32x2*)(vb) = (u32x2){sv0##X.x, sv0##X.y}; *(LAS u32x2*)(vb + 8) = (u32x2){sv0##X.z, sv0##X.w}; \
        *(LAS u32x2*)(vb + 64 * MLA_VROW) = (u32x2){sv1##X.x, sv1##X.y}; *(LAS u32x2*)(vb + 64 * MLA_VROW + 8) = (u32x2){sv1##X.z, sv1##X.w}; } while (0)
    MLA_LOAD(0, A); MLA_LOAD(1, B);
    bf16x8 qf[12];
    { const GAS bf16* qp = q + (rowb + q0 + 32 * rg + r) * 768 + 192 * h + 8 * hb;
#pragma unroll
      for (int s = 0; s < 12; ++s) qf[s] = *(const GAS bf16x8*)(qp + 16 * s); }
    MLA_STORE(0, A);
    __syncthreads();
    float m = -1e30f, lsum = 0.f; f32x16 O[4];
#pragma unroll
    for (int d = 0; d < 4; ++d) O[d] = zero16();
#define MLA_STEP(j, X, Y) do { \
        if ((j) + 1 < NS) MLA_STORE(((j) + 1) & 1, X);        \
        if ((j) + 2 < NS) MLA_LOAD((j) + 2, Y); \
        mla_compute(j); \
        __syncthreads(); } while (0)
    auto mla_compute = [&](int j) __attribute__((always_inline)) {
        const int taup = 2 * j + kp - 4 * qblk;
        if (taup <= rg) {
            const LAS unsigned char* sb = lds + (j & 1) * MLA_STG;
            f32x16 S = zero16();
            const LAS unsigned char* kpn = sb + (32 * kp + r) * MLA_KROW + hb * 16;
#pragma unroll
            for (int s = 0; s < 12; ++s) { const bf16x8 kf = *(const LAS bf16x8*)(kpn + s * 32); S = MFMA32(kf, qf[s], S); }
            if (taup == rg) {
#pragma unroll
                for (int i = 0; i < 16; ++i) if (crow(i, hb) > r) S[i] = -1e30f; }
            float mt = S[0];
#pragma unroll
            for (int i = 1; i < 16; ++i) mt = fmaxf(mt, S[i]);
            mt = fmaxf(mt, __shfl_xor(mt, 32));
            const float mn = fmaxf(m, mt);
            if (__any(mt > m)) {
                const float al = fast_exp2(m - mn); lsum *= al;
#pragma unroll
                for (int d = 0; d < 4; ++d) O[d] *= al; }
            m = mn;
            float ps = 0.f;
#pragma unroll
            for (int i = 0; i < 16; ++i) { const float p = fast_exp2(S[i] - mn); S[i] = p; ps += p; }
            lsum += ps;
            bf16x8 pf[2];
#pragma unroll
            for (int s = 0; s < 2; ++s) { u32x4 w = {pk2(S[8 * s], S[8 * s + 1]), pk2(S[8 * s + 2], S[8 * s + 3]), pk2(S[8 * s + 4], S[8 * s + 5]), pk2(S[8 * s + 6], S[8 * s + 7])}; pf[s] = __builtin_bit_cast(bf16x8, w); }
            const LAS unsigned char* vpn = sb + MLA_KBYTES + r * MLA_VROW + (32 * kp + 4 * hb) * 2;
#pragma unroll
            for (int d = 0; d < 4; ++d)
#pragma unroll
                for (int s = 0; s < 2; ++s) { const LAS unsigned char* vp = vpn + 32 * d * MLA_VROW + 32 * s;
                    const s16x4 lo = *(const LAS s16x4*)vp, hi = *(const LAS s16x4*)(vp + 16);
                    O[d] = MFMA32(__builtin_shufflevector(lo, hi, 0, 1, 2, 3, 4, 5, 6, 7), pf[s], O[d]); }
        }
    };
#pragma unroll 1
    for (int j = 0; j < NS; j += 2) { MLA_STEP(j, B, A); MLA_STEP(j + 1, A, B); }
#undef MLA_STEP
#undef MLA_LOAD
#undef MLA_STORE
    lsum += __shfl_xor(lsum, 32);
    LAS float* xo = (LAS float*)lds;
    LAS float* xm = (LAS float*)(lds + 65536);
    if (kp == 1) {
#pragma unroll
        for (int d = 0; d < 4; ++d)
#pragma unroll
            for (int i = 0; i < 16; ++i) xo[(rg * 64 + d * 16 + i) * 64 + lane] = O[d][i];
        xm[(rg * 2 + 0) * 64 + lane] = m; xm[(rg * 2 + 1) * 64 + lane] = lsum;
    }
    __syncthreads();
    if (kp == 0) {
        const float m1 = xm[(rg * 2 + 0) * 64 + lane], l1 = xm[(rg * 2 + 1) * 64 + lane];
        const float mn = fmaxf(m, m1), a0 = fast_exp2(m - mn), a1 = fast_exp2(m1 - mn);
        const float inv = 1.0f / (lsum * a0 + l1 * a1);
        const float c0 = a0 * inv, c1 = a1 * inv;
        GAS bf16* op = br + (rowb + q0 + 32 * rg + r) * D + 1024 + 128 * h;
#pragma unroll
        for (int d = 0; d < 4; ++d)
#pragma unroll
            for (int ig = 0; ig < 4; ++ig) { float v[4];
#pragma unroll
                for (int e = 0; e < 4; ++e) v[e] = O[d][4 * ig + e] * c0 + xo[(rg * 64 + d * 16 + 4 * ig + e) * 64 + lane] * c1;
                *(GAS u32x2*)(op + 32 * d + 8 * ig + 4 * hb) = (u32x2){pk2(v[0], v[1]), pk2(v[2], v[3])}; }
    }
    __syncthreads();
}

DI void mla_phase(Frame& F, const GAS bf16* q, const GAS bf16* kn, const GAS bf16* kpe, const GAS bf16* vt, GAS bf16* br) {
    for (int p = F.vcu; p < 256; p += F.G) { const int bh = p >> 4, i = p & 15;
        mla_unit(F, bh >> 2, bh & 3, 31 - i, q, kn, kpe, vt, br);
        mla_unit(F, bh >> 2, bh & 3, i, q, kn, kpe, vt, br); }
}
#ifdef PEER_NT
#define NTLD(p) __builtin_nontemporal_load(p)
#define NTST(p, v) __builtin_nontemporal_store((v), (p))
#else
#define NTLD(p) (*(p))
#define NTST(p, v) (*(p) = (v))
#endif
DI void ln1_phase(Frame& F, GAS float* y, GAS bf16* hbv, const GAS float* g, const GAS float* bta) {
    const int gw = F.vcu * NWAVES + F.wave, NGW = F.G * NWAVES, lane = F.lane;
    for (int row = gw; row < T; row += NGW) {
        GAS float* yr = y + (size_t)row * D + 4 * lane; f32x4 v[8]; float s = 0.f;
#pragma unroll
        for (int q = 0; q < 8; ++q) v[q] = *(const GAS f32x4*)(yr + 256 * q);
#pragma unroll
        for (int k = 0; k < 8; ++k) s += (v[k][0] + v[k][1]) + (v[k][2] + v[k][3]);
        const float mean = wave_sum(s) * (1.0f / D); float s2 = 0.f;
#pragma unroll
        for (int k = 0; k < 8; ++k) { v[k] = v[k] - mean; s2 += (v[k][0] * v[k][0] + v[k][1] * v[k][1]) + (v[k][2] * v[k][2] + v[k][3] * v[k][3]); }
        const float rstd = 1.0f / sqrtf(wave_sum(s2) * (1.0f / D) + NORM_EPS);
#pragma unroll
        for (int q = 0; q < 8; ++q) { const int c = 256 * q + 4 * lane;
            const f32x4 o0 = v[q] * rstd * *(const GAS f32x4*)(g + c) + *(const GAS f32x4*)(bta + c);
            *(GAS f32x4*)(yr + 256 * q) = o0;
            *(GAS u32x2*)(hbv + (size_t)row * D + c) = (u32x2){pk2(o0[0], o0[1]), pk2(o0[2], o0[3])}; }
    }
}

DI float gelu_erf(float a) { return 0.5f * a * (1.0f + erff(a * 0.70710678118654752f)); }

constexpr int PEER_G1OFF = 3072, PEER_B1OFF = 4096, PEER_G2OFF = 5120, PEER_B2OFF = 6144;
constexpr int PEER_WLDS = 16384;
DI void ins16k(float (&a)[16], float v) {
#pragma unroll
    for (int k = 15; k >= 1; --k) a[k] = __builtin_amdgcn_fmed3f(a[k - 1], a[k], v);
    a[0] = fmaxf(a[0], v);
}
DI void peer_topk4(LAS unsigned char* wl, const GAS bf16* sc, int tok0, int slot0) {
    const int lane = lane_id_opaque();
    LAS float* LV = (LAS float*)wl; LAS int* LI = (LAS int*)(wl + 4096);
    LAS int* EX = (LAS int*)(wl + 8192); LAS float* GT = (LAS float*)(wl + 12288);
    { float key[16];
#pragma unroll
      for (int k = 0; k < 16; ++k) key[k] = -3.0e38f;
      const int g4 = lane >> 4, c16 = lane & 15;
      const GAS bf16* sp = sc + (size_t)(tok0 + g4) * D + c16 * 8;
      u32x4 sw[16], sv[16];
#pragma unroll
      for (int k = 0; k < 16; ++k) sw[k] = *(const GAS u32x4*)(sp + k * 128);
      LAS u32x4* TL = (LAS u32x4*)wl;
#pragma unroll
      for (int hf = 0; hf < 2; ++hf) {
#pragma unroll
          for (int k = 0; k < 8; ++k) TL[(g4 * 8 + k) * 16 + (c16 ^ k)] = sw[8 * hf + k];
          LDS_WAIT(); asm volatile("" ::: "memory");
          if ((c16 >> 3) == hf) {
#pragma unroll
              for (int n = 0; n < 16; ++n) sv[n] = TL[(g4 * 8 + (c16 & 7)) * 16 + (n ^ (c16 & 7))]; }
          LDS_WAIT(); asm volatile("" ::: "memory"); }
#pragma unroll
      for (int n = 0; n < 16; ++n)
#pragma unroll
          for (int e = 0; e < 4; ++e) { const unsigned w = sv[n][e]; const int i0 = 8 * n + 2 * e;
              ins16k(key, __uint_as_float((w << 16) | (unsigned)(127 - i0)));
              ins16k(key, __uint_as_float((w & 0xffff0000u) | (unsigned)(126 - i0))); }
#pragma unroll
      for (int k = 0; k < 16; ++k) { const unsigned b = __float_as_uint(key[k]); LV[lane * 16 + k] = __uint_as_float(b & 0xffffff80u); LI[lane * 16 + k] = 127 - (int)(b & 127u); } }
    LDS_WAIT(); asm volatile("" ::: "memory");
    if (lane < 32) { const int it0 = (lane >> 3) * 16 + (lane & 7) * 2;
        float s0[16], s1[16];
#pragma unroll
        for (int k = 0; k < 16; ++k) { s0[k] = LV[it0 * 16 + k]; s1[k] = LV[(it0 + 1) * 16 + k]; }
        float key[16];
#pragma unroll
        for (int k = 0; k < 16; ++k) key[k] = -3.0e38f;
#pragma unroll
        for (int a = 0; a < 16; ++a)
#pragma unroll
            for (int b = 0; b < 16; ++b) if ((a + 1) * (b + 1) <= 16) ins16k(key, __uint_as_float((__float_as_uint(s0[a] + s1[b]) & 0xffffff00u) | (unsigned)(255 - (a * 16 + b))));
        float val[16], e[16], den = 0.f; int idx[16];
#pragma unroll
        for (int k = 0; k < 16; ++k) { const unsigned b = __float_as_uint(key[k]); val[k] = __uint_as_float(b & 0xffffff00u); idx[k] = 255 - (int)(b & 255u); }
#pragma unroll
        for (int k = 0; k < 16; ++k) { e[k] = __expf(val[k] - val[0]); den += e[k]; }
        const float inv = 1.0f / den; const int ob = (slot0 + (lane >> 3)) * 128 + (lane & 7) * 16;
#pragma unroll
        for (int k = 0; k < 16; ++k) { const int i1 = LI[it0 * 16 + (idx[k] >> 4)], i2 = LI[(it0 + 1) * 16 + (idx[k] & 15)];
            EX[ob + k] = i1 * 128 + i2; GT[ob + k] = e[k] * inv; } }
    LDS_WAIT(); asm volatile("" ::: "memory");
}

#ifndef PEER_RD
#define PEER_RD 2
#endif
constexpr int PEER_NB = 8;
constexpr int PEER_RDEP = PEER_RD;
#ifdef DUP_LOAD
struct RowFrag { u32x4 a; u32x2 b; u32x4 a2; };
#elif defined(DUP_LD4)
struct RowFrag { u32x4 a; u32x2 b; unsigned a2; };
#else
struct RowFrag { u32x4 a; u32x2 b; };
#endif
DI RowFrag row_load(const GAS unsigned char* tab, int e, int lane) { const GAS unsigned char* rp = tab + (size_t)e * ROWB; RowFrag f; f.a = *(const GAS u32x4*)(rp + 16 * lane); f.b = *(const GAS u32x2*)(rp + 1024 + 8 * lane);
#ifdef DUP_LOAD
    f.a2 = *(const GAS u32x4*)(tab + (size_t)((e + 7777) & 16383) * ROWB + 16 * lane);
#elif defined(DUP_LD4)
    f.a2 = *(const GAS unsigned*)(rp + 4 * lane);
#endif
    return f; }
DI f32x32 row_unpack(const RowFrag& f) { const u32x6 w = {f.a[0], f.a[1], f.a[2], f.a[3], f.b[0], f.b[1]};
#if defined(DUP_LOAD) || defined(DUP_LD4)
    asm volatile("" :: "v"(f.a2));
#endif
#ifdef DUP_UNPACK
    { f32x32 dummy; asm volatile("v_cvt_scalef32_pk32_f32_fp6 %0, %1, 1.0" : "=v"(dummy) : "v"(w)); asm volatile("" :: "v"(dummy)); }
#endif
#ifdef DUP_FMA
    { f32x2 d0 = {0.f, 0.f}, d1 = {1.f, 1.f}; asm volatile("" : "+v"(d0), "+v"(d1));
      for (int i = 0; i < 16; ++i) asm volatile("v_pk_fma_f32 %0, %1, %1, %0" : "+v"(d0) : "v"(d1)); asm volatile("" :: "v"(d0)); }
#endif
    return __builtin_amdgcn_cvt_scalef32_pk32_f32_fp6(w, 1.0f); }

DI void time_sync(unsigned* word, unsigned target, int wave) {
    __syncthreads();
    if (wave == 0 && lane_id_opaque() == 0) { __hip_atomic_fetch_add(word, 1u, __ATOMIC_RELAXED, __HIP_MEMORY_SCOPE_AGENT); unsigned sp = 0;
        while (__hip_atomic_load(word, __ATOMIC_RELAXED, __HIP_MEMORY_SCOPE_AGENT) < target) { __builtin_amdgcn_s_sleep(1); if (++sp > (1u << 22)) break; } }
    __syncthreads();
}
template <class BarT> DI void peer_wg(Frame& F, const BarT& gbar, int tsl, int chunk64, const GAS bf16* sc, const GAS bf16* yb16, const GAS float* hrow, const GAS float* st, const GAS float* g1, const GAS float* b1, const GAS unsigned char* tabu, const GAS unsigned char* tabv, const GAS float* g2, const GAS float* b2, GAS float* xout, GAS bf16* xbout) {
    const int lane = F.lane, w = F.wave; const int tokw = chunk64 * 64 + 8 * w;
    LAS unsigned char* wl = F.lds + w * PEER_WLDS;
    LAS int* EX = (LAS int*)(wl + 8192); LAS float* GT = (LAS float*)(wl + 12288);
    LAS float* AV = (LAS float*)(wl + 1088);
    LAS float* CV = (LAS float*)(wl + 1600);
    LAS int* CN = (LAS int*)(wl + 2112);
    LAS int* BS = (LAS int*)(wl + 2368);
    peer_topk4(wl, sc, tokw, 0);
    peer_topk4(wl, sc, tokw + 4, 4);
    { const int lc = lane_id_opaque();
      *(LAS f32x4*)(wl + PEER_G1OFF + 16 * lc) = *(const GAS f32x4*)(g1 + 256 * w + 4 * lc); *(LAS f32x4*)(wl + PEER_B1OFF + 16 * lc) = *(const GAS f32x4*)(b1 + 256 * w + 4 * lc);
      *(LAS f32x4*)(wl + PEER_G2OFF + 16 * lc) = *(const GAS f32x4*)(g2 + 256 * w + 4 * lc); *(LAS f32x4*)(wl + PEER_B2OFF + 16 * lc) = *(const GAS f32x4*)(b2 + 256 * w + 4 * lc); }
    __syncthreads();
#define PEER_SO(r) ((LAS int*)(wl + ((r) & 1) * 544))
#define PEER_SORT(r) do { LAS int* so_ = PEER_SO(r); CN[lane] = 0; LDS_WAIT(); asm volatile("" ::: "memory"); int ev_[2], pos_[2]; \
        _Pragma("unroll") for (int q = 0; q < 2; ++q) { ev_[q] = EX[(r) * 128 + lane + 64 * q]; pos_[q] = __hip_atomic_fetch_add(&CN[ev_[q] >> 8], 1, __ATOMIC_RELAXED, __HIP_MEMORY_SCOPE_WAVEFRONT); } \
        LDS_WAIT(); asm volatile("" ::: "memory"); \
        { const int c = CN[lane]; int inc = c; _Pragma("unroll") for (int o = 1; o < 64; o <<= 1) { const int t_ = __shfl_up(inc, o); if (lane >= o) inc += t_; } BS[lane] = inc - c; } \
        LDS_WAIT(); asm volatile("" ::: "memory"); \
        _Pragma("unroll") for (int q = 0; q < 2; ++q) so_[BS[ev_[q] >> 8] + pos_[q]] = ev_[q] | ((lane + 64 * q) << 14); \
        if (lane < PEER_NB) so_[128 + lane] = 0; \
        LDS_WAIT(); asm volatile("" ::: "memory"); } while (0)
    RowFrag bu[PEER_RDEP];
    PEER_SORT(0);
    { LAS int* so = PEER_SO(0);
#pragma unroll
      for (int b = 0; b < PEER_RDEP; ++b) bu[b] = row_load(tabu, __builtin_amdgcn_readfirstlane(so[b]) & 16383, lane); }
#pragma unroll 1
    for (int r = 0; r < 8; ++r) {
        LAS int* SO = PEER_SO(r);
        const int t = tokw + r; const GAS float* hr = hrow + (size_t)t * D;
        const float mu1 = st[2 * t] * (1.0f / D), rs1 = 1.0f / sqrtf(st[2 * t + 1] * (1.0f / D) - mu1 * mu1 + NORM_EPS);
#define LNH(q, ln) ((*(const GAS f32x4*)(hr + 256 * (q) + 4 * (ln)) - mu1) * rs1 * *(const LAS f32x4*)(F.lds + (q) * PEER_WLDS + PEER_G1OFF + 16 * (ln)) + *(const LAS f32x4*)(F.lds + (q) * PEER_WLDS + PEER_B1OFF + 16 * (ln)))
        f32x2 hv[16];
        { { float hh[32]; const int lnh = lane_id_opaque();
#pragma unroll
            for (int q = 0; q < 8; ++q) { const f32x4 a = LNH(q, lnh); hh[4 * q] = a[0]; hh[4 * q + 1] = a[1]; hh[4 * q + 2] = a[2]; hh[4 * q + 3] = a[3]; }
#pragma unroll
            for (int i = 0; i < 16; ++i) hv[i] = (f32x2){hh[fp6_map(2 * i)], hh[fp6_map(2 * i + 1)]}; }
#pragma unroll 1
          for (int base = 0; base < 128; base += PEER_NB) {
              float part[PEER_NB];
#pragma unroll
              for (int b = 0; b < PEER_NB; ++b) {
                  __builtin_amdgcn_s_setprio(2);
                  const f32x32 f = row_unpack(bu[b % PEER_RDEP]);
                  { const int nx = base + PEER_RDEP + b;
                    if (nx < 128) bu[b % PEER_RDEP] = row_load(tabu, __builtin_amdgcn_readfirstlane(SO[nx]) & 16383, lane);
                    else bu[b % PEER_RDEP] = row_load(tabv, __builtin_amdgcn_readfirstlane(SO[nx - 128]) & 16383, lane); }
                  __builtin_amdgcn_s_setprio(0);
                  f32x2 a0 = {0.f, 0.f}, a1 = {0.f, 0.f}, a2 = {0.f, 0.f}, a3 = {0.f, 0.f};
#pragma unroll
                  for (int i = 0; i < 16; i += 4) { a0 += (f32x2){f[2 * i], f[2 * i + 1]} * hv[i]; a1 += (f32x2){f[2 * i + 2], f[2 * i + 3]} * hv[i + 1];
                      a2 += (f32x2){f[2 * i + 4], f[2 * i + 5]} * hv[i + 2]; a3 += (f32x2){f[2 * i + 6], f[2 * i + 7]} * hv[i + 3]; }
                  a0 = (a0 + a1) + (a2 + a3);
                  part[b] = a0.x + a0.y;
#ifdef PEER_PIN
                  asm volatile("" ::: "memory");
#endif
              }
              const bool h5 = lane & 32, h4 = lane & 16, h3 = lane & 8; const int pidx = 4 * ((lane >> 3) & 1) + 2 * ((lane >> 4) & 1) + (lane >> 5);
#pragma unroll
              for (int g = 0; g < PEER_NB; g += 8) {
                  float r4[4], r2[2];
#pragma unroll
                  for (int i = 0; i < 4; ++i) { const float x = h5 ? part[g + 2 * i] : part[g + 2 * i + 1], y = h5 ? part[g + 2 * i + 1] : part[g + 2 * i]; r4[i] = y + __shfl_xor(x, 32); }
#pragma unroll
                  for (int i = 0; i < 2; ++i) { const float x = h4 ? r4[2 * i] : r4[2 * i + 1], y = h4 ? r4[2 * i + 1] : r4[2 * i]; r2[i] = y + __shfl_xor(x, 16); }
                  float tt; { const float x = h3 ? r2[0] : r2[1], y = h3 ? r2[1] : r2[0]; tt = y + __shfl_xor(x, 8); }
                  tt += __shfl_xor(tt, 4); tt += __shfl_xor(tt, 2); tt += __shfl_xor(tt, 1);
                  const int mm = SO[base + g + pidx];
                  if ((lane & 7) == 0) AV[mm >> 14] = tt * (1.0f / U_SCALE); } } }
        LDS_WAIT(); asm volatile("" ::: "memory");
#pragma unroll
        for (int q = 0; q < 2; ++q) { const int k = lane + 64 * q; CV[k] = GT[r * 128 + k] * gelu_erf(AV[k]) * (1.0f / V_SCALE); }
        LDS_WAIT(); asm volatile("" ::: "memory");
        if (r + 1 < 8) PEER_SORT(r + 1);
        f32x2 o[16];
#pragma unroll
        for (int k = 0; k < 16; ++k) o[k] = (f32x2){0.f, 0.f};
        { LAS int* SN = PEER_SO(r + 1);
#pragma unroll 1
          for (int base = 0; base < 128; base += PEER_NB) {
#pragma unroll
              for (int b = 0; b < PEER_NB; ++b) {
                  const float cf = CV[(SO[base + b] >> 14) & 127];
                  __builtin_amdgcn_s_setprio(2);
                  const f32x32 f = row_unpack(bu[b % PEER_RDEP]);
                  { const int nx = base + PEER_RDEP + b;
                    if (nx < 128) bu[b % PEER_RDEP] = row_load(tabv, __builtin_amdgcn_readfirstlane(SO[nx]) & 16383, lane);
                    else bu[b % PEER_RDEP] = row_load(tabu, __builtin_amdgcn_readfirstlane(SN[nx - 128]) & 16383, lane); }
                  __builtin_amdgcn_s_setprio(0);
#pragma unroll
                  for (int i = 0; i < 16; ++i) { const f32x2 v = {f[2 * i], f[2 * i + 1]}; o[i] += cf * v; }
#ifdef PEER_PIN
                  asm volatile("" ::: "memory");
#endif
              } } }
        { float y[32];
#pragma unroll
          for (int i = 0; i < 16; ++i) { y[fp6_map(2 * i)] = o[i].x + DN_ALPHA * hv[i].x; y[fp6_map(2 * i + 1)] = o[i].y + DN_ALPHA * hv[i].y; }
          float s = 0.f; const int ln2 = lane_id_opaque();
#pragma unroll
          for (int k = 0; k < 32; ++k) s += y[k];
          const float mean = wave_sum(s) * (1.0f / D); float s2 = 0.f;
#pragma unroll
          for (int k = 0; k < 32; ++k) { y[k] -= mean; s2 += y[k] * y[k]; }
          const float rstd = 1.0f / sqrtf(wave_sum(s2) * (1.0f / D) + NORM_EPS);
#pragma unroll
          for (int q = 0; q < 8; ++q) { const int c = 256 * q + 4 * ln2; const f32x4 gg = *(const LAS f32x4*)(F.lds + q * PEER_WLDS + PEER_G2OFF + 16 * ln2), bb = *(const LAS f32x4*)(F.lds + q * PEER_WLDS + PEER_B2OFF + 16 * ln2);
              const f32x4 rr = (f32x4){y[4 * q], y[4 * q + 1], y[4 * q + 2], y[4 * q + 3]} * rstd * gg + bb;
              NTST((GAS f32x4*)(xout + (size_t)t * D + c), rr);
              if (xbout) NTST((GAS u32x2*)(xbout + (size_t)t * D + c), ((u32x2){pk2(rr[0], rr[1]), pk2(rr[2], rr[3])}));
              if (q & 1) asm volatile("" ::: "memory"); } }
    }
    __syncthreads();
#undef PEER_SO
#undef PEER_SORT
}
#undef LNH
#ifndef DUPMASK
#define DUPMASK 0
#endif
#ifndef CSEL
#define CSEL 7
#endif
#ifndef PHMASK
#define PHMASK 1023
#endif
constexpr int NPH = 1 + 9 * DEPTH;
__global__ void __launch_bounds__(NWAVES * 64, 2) mega_fwd(Args args) {
    extern __shared__ __attribute__((aligned(16))) unsigned char lds_raw[];
    Frame F;
    F.lds = (LAS unsigned char*)lds_raw;
    F.wave = __builtin_amdgcn_readfirstlane(threadIdx.x >> 6); F.lane = lane_id_opaque(); F.tid = F.wave * 64 + F.lane;
#define RELANE() do { F.lane = lane_id_opaque(); F.tid = F.wave * 64 + F.lane; } while (0)
    F.G = gridDim.x; { const int bx = blockIdx.x; F.vcu = (F.G % 8 == 0) ? (bx % 8) * (F.G / 8) + bx / 8 : bx; }
    F.ws = (GAS unsigned char*)args.ws;
    unsigned* ctl = (unsigned*)(args.ws + WS_CTL);
    for (int u = threadIdx.x; u < (LDS_BYTES - LDSCTL_OFF) / 4; u += NWAVES * 64) ((LAS unsigned*)(F.lds + LDSCTL_OFF))[u] = 0u;
    __syncthreads();
    XcdBarrier bar; bar.bar = ctl + CW_BAR; bar.x = 0; bar.st = nullptr; bar.wave = F.wave;
#if !MK_PER_PHASE
    bar = xcd_barrier_post(ctl + CW_BAR, (volatile LAS unsigned*)(F.lds + MISC_OFF) + 8, F.wave);
#endif
    const int lo = args.ph_lo, hi = args.ph_hi;
#define IN(k) (lo <= (k) && (k) < hi)
#if MK_PER_PHASE
#define SEAM(k) do { } while (0)
#else
#define SEAM(k) do { if (IN(k) && IN((k) + 1)) xcd_barrier(bar); } while (0)
#endif
    const int bid = (int)blockIdx.x, G = F.G;

#ifdef BENCH
    { f32x32 bo; u32x6 bi = {1u, 2u, 3u, 4u, 5u, 6u}; u32x16 bo16; f32x2 p0 = {1.f, 2.f}, p1 = {0.5f, 0.25f}, p2 = {0.f, 0.f}; float q0 = 1.f, q1 = 0.5f, q2 = 0.f; unsigned w0 = 0x3f803f80u, w1 = 0x3f003f00u; int i0 = 0x01020304, i1 = 0x04030201, i2 = 0; unsigned ub = 0x80402010u;
      asm volatile("" : "+v"(bi), "+v"(p0), "+v"(p1), "+v"(q0), "+v"(q1), "+v"(w0), "+v"(w1), "+v"(i0), "+v"(i1), "+v"(ub));
#pragma unroll 1
      for (int it = 0; it < BENCH_N; ++it) {
#define R16(x) x x x x x x x x x x x x x x x x
#if BENCH == 1
          R16(asm volatile("v_cvt_scalef32_pk32_f32_fp6 %0, %1, 1.0" : "=v"(bo) : "v"(bi));)
#elif BENCH == 2
          R16(asm volatile("v_cvt_scalef32_pk32_bf16_fp6 %0, %1, 1.0" : "=v"(bo16) : "v"(bi));)
#elif BENCH == 3
          R16(asm volatile("v_pk_fma_f32 %0, %1, %2, %0" : "+v"(p2) : "v"(p0), "v"(p1));)
#elif BENCH == 4
          R16(asm volatile("v_fma_f32 %0, %1, %2, %0" : "+v"(q2) : "v"(q0), "v"(q1));)
#elif BENCH == 5
          R16(asm volatile("v_dot2c_f32_bf16 %0, %1, %2" : "+v"(q2) : "v"(w0), "v"(w1));)
#elif BENCH == 6
          R16(asm volatile("v_dot4_i32_i8 %0, %1, %2, %0" : "+v"(i2) : "v"(i0), "v"(i1));)
#elif BENCH == 7
          R16(asm volatile("v_cvt_f32_ubyte1 %0, %1" : "=v"(q2) : "v"(ub));)
#elif BENCH == 8
          R16(asm volatile("v_cvt_pk_f32_fp8 %0, %1" : "=v"(p2) : "v"(ub));)
#elif BENCH == 9
          { f32x2 z[16]; for (int i_ = 0; i_ < 16; ++i_) asm volatile("v_pk_fma_f32 %0, %1, %2, %1" : "=v"(z[i_]) : "v"(p0), "v"(p1)); for (int i_ = 0; i_ < 16; ++i_) asm volatile("" :: "v"(z[i_])); }
#elif BENCH == 10
          { float z[16]; for (int i_ = 0; i_ < 16; ++i_) asm volatile("v_fma_f32 %0, %1, %2, %1" : "=v"(z[i_]) : "v"(q0), "v"(q1)); for (int i_ = 0; i_ < 16; ++i_) asm volatile("" :: "v"(z[i_])); }
#endif
      }
      asm volatile("" :: "v"(bo), "v"(bo16), "v"(p2), "v"(q2), "v"(i2)); }
#endif
    if (((PHMASK >> 0) & 1) && IN(0)) for (int rep_ = 0; rep_ < ((((DUPMASK) >> 0) & 1) ? 2 : 1); ++rep_) { RELANE(); p0_prologue(F, args); }
    SEAM(0);
#pragma unroll 1
    for (int l = 0; l < DEPTH; ++l) {
        const int pb = 1 + 9 * l;
        GAS unsigned char* ws = (GAS unsigned char*)args.ws; asm volatile("" : "+s"(ws));
        GAS bf16* XB = (GAS bf16*)(ws + WS_XB); GAS float* XA = (GAS float*)(ws + WS_XA);
        GAS bf16* GATES = (GAS bf16*)(ws + WS_R1); GAS float* Y = (GAS float*)(ws + WS_R1); GAS bf16* SC = (GAS bf16*)(ws + WS_R1 + (size_t)T * D * 4);
        GAS bf16* HM = (GAS bf16*)(ws + WS_HM); GAS bf16* BR = (GAS bf16*)(ws + WS_BR); GAS bf16* PY = (GAS bf16*)(ws + WS_PY); GAS bf16* KPE = (GAS bf16*)(ws + WS_KPE); GAS float* RS = (GAS float*)(ws + WS_RS);
        GAS bf16* Q = (GAS bf16*)(ws + WS_Q); GAS bf16* KN = (GAS bf16*)(ws + WS_KN); GAS bf16* VT = (GAS bf16*)(ws + WS_VT);
        GAS bf16* MG = (GAS bf16*)(ws + WS_MG); GAS bf16* YB = (GAS bf16*)(ws + WS_HB); GAS float* ST = (GAS float*)(ws + WS_ST);
        const GAS float* CSl = (const GAS float*)(ws + WS_CTL) + CW_CS + l * 2048; const GAS float* BWl = (const GAS float*)(ws + WS_CTL) + CW_BW + l * 2048;
        const GAS float* cosb = (const GAS float*)(ws + WS_ROPE); const GAS float* sinb = cosb + SEQ * 32;
        if (((PHMASK >> 1) & 1) && IN(pb + 0)) for (int rep_ = 0; rep_ < ((((DUPMASK) >> 1) & 1) ? 2 : 1); ++rep_) {
            pg8::Gemm g{XB, (const GAS bf16*)(ws + WS_WIN + l * SZ_WIN), D, D, D}; pg8::StaticOrder S; S.init(T, N1, G, bid);
            pg8::EpiGemm1 E{GATES, HM};
            pg8::gemm_phase(F.lds, F.wave, g, S, E);
        }
        SEAM(pb + 0);
        if (((PHMASK >> 2) & 1) && IN(pb + 1)) for (int rep_ = 0; rep_ < ((((DUPMASK) >> 2) & 1) ? 2 : 1); ++rep_) {
            RELANE();
            for (int u = F.vcu; u < 256; u += G) swa_unit(F, u, HM, BR, ((const GAS float*)args.in[3]) + l * 8);
            for (int ch = F.vcu; ch < 256; ch += G) elem_chunk(F, ch, HM, BR, PY, KPE, RS, ST, ((const GAS float*)args.in[2]) + l * 3 * 512, cosb, sinb);
        }
        SEAM(pb + 1);
        if (((PHMASK >> 3) & 1) && IN(pb + 2)) for (int rep_ = 0; rep_ < ((((DUPMASK) >> 3) & 1) ? 2 : 1); ++rep_) {
            if (CSEL & 1) { pg8::Gemm g{HM + C_CQ, (const GAS bf16*)(ws + WS_WQUP + l * SZ_WQUP), 512, HM_LD, 512}; pg8::StaticOrder S; S.init(T, 768, G, bid);
              pg8::EpiQ E{Q, RS, cosb, sinb}; pg8::gemm_phase(F.lds, F.wave, g, S, E); }
            if (CSEL & 2) { pg8::Gemm g{HM + C_CKV, (const GAS bf16*)(ws + WS_WKVUP + l * SZ_WKVUP), 256, HM_LD, 256}; pg8::StaticOrder S; S.init(T, 1024, G, bid);
              pg8::EpiKV E{KN, VT, RS}; pg8::gemm_phase(F.lds, F.wave, g, S, E); }
            if (CSEL & 4) { pg8::Gemm g{PY, (const GAS bf16*)(ws + WS_WPOOL + l * SZ_WPOOL), 512, 512, 512}; pg8::StaticOrder S; S.init(T, 512, G, (bid + 64) % G);
              pg8::EpiPool E{BR, ((const GAS float*)args.in[9]) + l * 512}; pg8::gemm_phase(F.lds, F.wave, g, S, E); }
        }
        SEAM(pb + 2);
        if (((PHMASK >> 4) & 1) && IN(pb + 3)) for (int rep_ = 0; rep_ < ((((DUPMASK) >> 4) & 1) ? 2 : 1); ++rep_) { RELANE(); mla_phase(F, Q, KN, KPE, VT, BR); }
        SEAM(pb + 3);
        if (((PHMASK >> 5) & 1) && IN(pb + 4)) for (int rep_ = 0; rep_ < ((((DUPMASK) >> 5) & 1) ? 2 : 1); ++rep_) {
            pg8::Gemm g{BR, (const GAS bf16*)(ws + WS_WBR + l * SZ_WBR), 512, D, 512}; pg8::MergeOrder S{G, bid};
            pg8::EpiMerge E{GATES, MG};
            pg8::gemm_phase(F.lds, F.wave, g, S, E);
        }
        SEAM(pb + 4);
        if (((PHMASK >> 6) & 1) && IN(pb + 5)) for (int rep_ = 0; rep_ < ((((DUPMASK) >> 6) & 1) ? 2 : 1); ++rep_) {
            pg8::Gemm g{MG, (const GAS bf16*)(ws + WS_WOUT + l * SZ_WSQ), D, D, D}; pg8::StaticOrder S; S.init(T, D, G, bid);
            pg8::EpiOut E{l == 0 ? ((const GAS float*)args.in[0]) : XA, Y, YB, ST};
            pg8::gemm_phase(F.lds, F.wave, g, S, E);
        }
        SEAM(pb + 5);
        if (((PHMASK >> 8) & 1) && IN(pb + 7)) for (int rep_ = 0; rep_ < ((((DUPMASK) >> 8) & 1) ? 2 : 1); ++rep_) {
            pg8::Gemm g{YB, (const GAS bf16*)(ws + WS_WPQ + l * SZ_WSQ), D, D, D}; pg8::StaticOrder S; S.init(T, D, G, bid);
            pg8::EpiScore E{SC, ST, CSl, BWl};
            pg8::gemm_phase(F.lds, F.wave, g, S, E);
        }
        SEAM(pb + 7);
        if (((PHMASK >> 9) & 1) && IN(pb + 8)) for (int rep_ = 0; rep_ < ((((DUPMASK) >> 9) & 1) ? 2 : 1); ++rep_) {
            RELANE(); const bool lastl = (l == DEPTH - 1);
#ifdef DBG_HALFPEER
            if ((((int)blockIdx.x >> 3) & 1) == 0)
            for (int ch = ((int)blockIdx.x & 7) * 16 + ((int)blockIdx.x >> 4); ch < T / 64; ch += G / 2)
#else
            for (int ch = F.vcu; ch < T / 64; ch += G)
#endif
                peer_wg(F, bar, l, ch, SC, YB, Y, ST, ((const GAS float*)args.in[12]) + l * D, ((const GAS float*)args.in[13]) + l * D, (const GAS unsigned char*)(ws + WS_TABU + l * SZ_TAB), (const GAS unsigned char*)(ws + WS_TABV + l * SZ_TAB), ((const GAS float*)args.in[18]) + l * D, ((const GAS float*)args.in[19]) + l * D,
                           lastl ? (GAS float*)args.out : XA, lastl ? (GAS bf16*)nullptr : XB);
        }
        if (l + 1 < DEPTH) SEAM(pb + 8);
    }
#undef IN
#undef SEAM
}

extern "C" void kernel_launch(void* const* d_in, const int* in_sizes, int n_in, void* d_out, int out_size, void* d_ws, size_t ws_size, hipStream_t stream) {
    static int grid = 0;
    if (grid == 0) {
        if (n_in != 20 || out_size != T * D || ws_size < WS_END) { fprintf(stderr, "kernel_launch: unexpected shapes (n_in %d, out %d, ws %zu need %zu)\n", n_in, out_size, ws_size, (size_t)WS_END); grid = -1; return; }
        int dev = 0, cus = 0, per_cu = 0;
        if (hipGetDevice(&dev) != hipSuccess || hipDeviceGetAttribute(&cus, hipDeviceAttributeMultiprocessorCount, dev) != hipSuccess) { grid = -1; return; }
        if (hipFuncSetAttribute((const void*)mega_fwd, hipFuncAttributeMaxDynamicSharedMemorySize, LDS_BYTES) != hipSuccess) { fprintf(stderr, "kernel_launch: hipFuncSetAttribute failed\n"); grid = -1; return; }
        if (hipOccupancyMaxActiveBlocksPerMultiprocessor(&per_cu, (const void*)mega_fwd, NWAVES * 64, LDS_BYTES) != hipSuccess || per_cu < 1) { fprintf(stderr, "kernel_launch: occupancy query says %d\n", per_cu); }
        (void)hipGetLastError();
        grid = cus;
    }
    if (grid < 0) return;
    if (hipMemsetAsync((char*)d_ws + WS_CTL, 0, CTL_ZERO_BYTES, stream) != hipSuccess) return;
    Args a{};
    for (int i = 0; i < 20; ++i) a.in[i] = (const float*)d_in[i];
    a.out = (float*)d_out; a.ws = (unsigned char*)d_ws;
#if MK_PER_PHASE
    for (int p = 0; p < NPH; ++p) { a.ph_lo = p; a.ph_hi = p + 1; hipLaunchKernelGGL(mega_fwd, dim3(grid), dim3(NWAVES * 64), LDS_BYTES, stream, a); }
#else
    a.ph_lo = 0; a.ph_hi = NPH;
    hipLaunchKernelGGL(mega_fwd, dim3(grid), dim3(NWAVES * 64), LDS_BYTES, stream, a);
#endif
}
```

```cpp
#define MK_PER_PHASE 0
#define PEER_PIN 1
#include <hip/hip_runtime.h>
#include <cstdio>
#include <cstdint>
#include <cmath>

#ifndef MK_PER_PHASE
#define MK_PER_PHASE 0
#endif

#define DI __device__ __forceinline__
#define LAS __attribute__((address_space(3)))
#define GAS __attribute__((address_space(1)))
typedef unsigned short bf16;
typedef short bf16x8 __attribute__((ext_vector_type(8)));
typedef short s16x4 __attribute__((ext_vector_type(4)));
typedef float f32x4 __attribute__((ext_vector_type(4)));
typedef float f32x2 __attribute__((ext_vector_type(2)));
typedef float f32x16 __attribute__((ext_vector_type(16)));
typedef float f32x32 __attribute__((ext_vector_type(32)));
typedef unsigned u32x6 __attribute__((ext_vector_type(6)));
typedef unsigned u32x16 __attribute__((ext_vector_type(16)));
typedef unsigned u32x4 __attribute__((ext_vector_type(4)));
typedef unsigned u32x2 __attribute__((ext_vector_type(2)));
typedef __bf16 bf16x2_t __attribute__((ext_vector_type(2)));
typedef __bf16 bf16x8_t __attribute__((ext_vector_type(8)));

constexpr int D = 2048, BATCH = 4, SEQ = 4096, T = BATCH * SEQ, DEPTH = 4;
constexpr int NGATE = 4 * D;
constexpr int NHM = 3648, HM_LD = 3840;
constexpr int N1 = NGATE + HM_LD;
constexpr int IN_DIM = 11840;
constexpr int C_CONVU = 0, C_CONVB = 512, C_CONVC = 1024, C_SWAQ = 1536, C_SWAK = 2048, C_SWAV = 2176, C_CQ = 2304, C_CKV = 2816, C_KR = 3072, C_POOL = 3136;
constexpr float DN_ALPHA = 1.681792830507429f;
constexpr float NORM_EPS = 1e-5f;
constexpr float LOG2E = 1.4426950408889634f;
constexpr int NEXP = 16384;

constexpr size_t MiB = 1u << 20;
constexpr size_t WS_CTL = 0, CTL_ZERO_BYTES = 1 * MiB;
constexpr size_t WS_WIN = 1 * MiB;
constexpr size_t SZ_WIN = (size_t)N1 * D * 2;
constexpr size_t WS_WQUP = WS_WIN + 4 * SZ_WIN;
constexpr size_t SZ_WQUP = 768 * 512 * 2;
constexpr size_t WS_WKVUP = WS_WQUP + 4 * SZ_WQUP;
constexpr size_t SZ_WKVUP = 1024 * 256 * 2;
constexpr size_t WS_WPOOL = WS_WKVUP + 4 * SZ_WKVUP;
constexpr size_t SZ_WPOOL = 512 * 512 * 2;
constexpr size_t WS_WBR = WS_WPOOL + 4 * SZ_WPOOL;
constexpr size_t SZ_WBR = (size_t)4 * D * 512 * 2;
constexpr size_t WS_WOUT = WS_WBR + 4 * SZ_WBR;
constexpr size_t SZ_WSQ = (size_t)D * D * 2;
constexpr size_t WS_WPQ = WS_WOUT + 4 * SZ_WSQ;
constexpr size_t WS_TABU = WS_WPQ + 4 * SZ_WSQ;
constexpr int ROWB = 1536;
constexpr size_t SZ_TAB = (size_t)NEXP * ROWB;
constexpr float U_SCALE = 80.f, V_SCALE = 48.f;
#ifndef FP6_INTERLEAVED
#define FP6_INTERLEAVED 1
#endif
DI constexpr int fp6_map(int j) { return FP6_INTERLEAVED ? (j >> 1) + 16 * (j & 1) : j; }
constexpr size_t WS_TABV = WS_TABU + 4 * SZ_TAB;
constexpr size_t WS_ROPE = WS_TABV + 4 * SZ_TAB;
constexpr size_t WS_XA = WS_ROPE + 1 * MiB;
constexpr size_t WS_XB = WS_XA + (size_t)T * D * 4;
constexpr size_t WS_R1 = WS_XB + (size_t)T * D * 2;
constexpr size_t WS_HM = WS_R1 + (size_t)T * NGATE * 2;
constexpr size_t WS_BR = WS_HM + (size_t)T * HM_LD * 2;
constexpr size_t WS_PY = WS_BR + (size_t)T * D * 2;
constexpr size_t WS_KPE = WS_PY + (size_t)T * 512 * 2;
constexpr size_t WS_RS = WS_KPE + (size_t)T * 64 * 2;
constexpr size_t WS_Q = WS_RS + 1 * MiB;
constexpr size_t WS_KN = WS_Q + (size_t)T * 768 * 2;
constexpr size_t WS_VT = WS_KN + (size_t)T * 512 * 2;
constexpr size_t WS_SLAB = WS_VT + (size_t)T * 512 * 2;
constexpr size_t WS_ST = WS_SLAB;
constexpr size_t WS_MG = WS_SLAB + (size_t)256 * 65536 * 4;
constexpr size_t WS_HB = WS_MG + (size_t)T * D * 2;
constexpr size_t WS_END = WS_HB + (size_t)T * D * 2;
static_assert(WS_END <= (size_t)2047 * MiB, "workspace map");

constexpr int CW_TMO = 0;
constexpr int CW_BAR = 4096;
constexpr int CW_CS = 65536, CW_BW = CW_CS + 4 * 2048;

constexpr int RING_BYTES = 131072;
constexpr int LDSCTL_OFF = RING_BYTES, MISC_OFF = LDSCTL_OFF + 320;
constexpr int LDS_BYTES = 147456;
constexpr int NWAVES = 8;

DI unsigned pk2(float lo, float hi) { f32x2 v = {lo, hi}; bf16x2_t b = __builtin_convertvector(v, bf16x2_t); return __builtin_bit_cast(unsigned, b); }
DI float bflo(unsigned u) { return __uint_as_float(u << 16); }
DI float bfhi(unsigned u) { return __uint_as_float(u & 0xffff0000u); }
DI float bf2f(bf16 b) { return __uint_as_float(((unsigned)b) << 16); }
DI bf16 f2bf(float f) { return (bf16)(pk2(f, 0.f) & 0xffffu); }
DI float wave_sum(float v) {
#pragma unroll
    for (int o = 1; o < 64; o <<= 1) v += __shfl_xor(v, o);
    return v;
}
DI float fast_exp2(float x) { return __builtin_amdgcn_exp2f(x); }
DI float fast_rcp(float x) { return __builtin_amdgcn_rcpf(x); }
#define LDS_WAIT() asm volatile("s_waitcnt lgkmcnt(0)" ::: "memory")
#define VM_WAIT() asm volatile("s_waitcnt vmcnt(0)" ::: "memory")
#define MFMA32(a, b, c) __builtin_amdgcn_mfma_f32_32x32x16_bf16((a), (b), (c), 0, 0, 0)
DI int crow(int reg, int h) { return (reg & 3) + 8 * (reg >> 2) + 4 * h; }
DI f32x4 ld4bf_lo(u32x4 w) { return (f32x4){bflo(w.x), bfhi(w.x), bflo(w.y), bfhi(w.y)}; }
DI f32x4 ld4bf_hi(u32x4 w) { return (f32x4){bflo(w.z), bfhi(w.z), bflo(w.w), bfhi(w.w)}; }
DI int lane_id_opaque() { int l; asm volatile("v_mbcnt_lo_u32_b32 %0, -1, 0\n\tv_mbcnt_hi_u32_b32 %0, -1, %0" : "=&v"(l)); return l; }
DI f32x16 zero16() { float z = 0.f; asm volatile("" : "+v"(z)); f32x16 r; for (int i = 0; i < 16; ++i) r[i] = z; return r; }
DI bf16x2_t cvt2(float lo, float hi) { f32x2 v = {lo, hi}; return __builtin_convertvector(v, bf16x2_t); }
namespace pg8 {
constexpr int BM = 256, BK = 64, HALF = 128, HTB = HALF * BK * 2, STAGE_BYTES = 8 * HTB, NXCD = 8, WGM = 8;
__host__ __device__ __forceinline__ int lds_byte(int r, int c) { const int st = (r >> 4) * 2 + (c >> 5), rr = r & 15, cc = c & 31, ob = rr * 64 + cc * 2; return st * 1024 + (ob ^ (((ob >> 9) & 1) << 5)); }
__host__ __device__ __forceinline__ void stage_rc(int b, int& R, int& C) { const int st = b / 1024, sb = b % 1024, swz = sb ^ (((sb >> 9) & 1) << 5); R = (st >> 1) * 16 + swz / 64; C = (st & 1) * 32 + (swz % 64) / 2; }
__host__ __device__ __forceinline__ int perm32(int rho) { const int n = rho >> 4, i = rho & 15; return 8 * (i >> 2) + 4 * n + (i & 3); }

struct Unit { int pm, pn, aoff; };
struct Gemm { const GAS bf16* A; const GAS bf16* Bt; int K, lda, ldb; };

__device__ __forceinline__ void tile_of(int L, int nM, int nN, int& pm, int& pn) {
    const int nwg = nM * nN; int wgid = L;
    { const int q = nwg / NXCD, r = nwg % NXCD, xcd = wgid % NXCD, off = wgid / NXCD; wgid = (xcd < r ? xcd * (q + 1) : r * (q + 1) + (xcd - r) * q) + off; }
    const int nig = WGM * nN, gid = wgid / nig, fm = gid * WGM, gsz = (nM - fm) < WGM ? (nM - fm) : WGM;
    pm = fm + ((wgid % nig) % gsz); pn = (wgid % nig) / gsz;
}
struct StaticOrder {
    int nM, nN, nwg, G, c;
    __device__ __forceinline__ void init(int M, int N, int G_, int c_) { nM = M / BM; nN = N / BM; nwg = nM * nN; G = G_; c = c_; }
    __device__ __forceinline__ bool next(int i, Unit& u) const {
        const long L = (long)i * G + c; if (L >= nwg) return false;
        tile_of((int)L, nM, nN, u.pm, u.pn); u.aoff = 0; return true;
    }
};
struct MergeOrder {
    int G, c;
    __device__ __forceinline__ bool next(int i, Unit& u) const {
        const long L = (long)(i >> 2) * G + c; if (L >= 512) return false;
        int pm, pn; tile_of((int)L, 64, 8, pm, pn); const int br = i & 3;
        u.pm = pm; u.pn = br * 8 + pn; u.aoff = br * 1024; return true;
    }
};

template <class Epi, class Sched>
__device__ __forceinline__ void gemm_phase(LAS unsigned char* lds, int wave_s, const Gemm g, const Sched& S, const Epi& E) {
    asm volatile("" : "+s"(wave_s));
    const int lane = lane_id_opaque(), wid = wave_s, tid = wid * 64 + lane, wr = wid >> 2, wc = wid & 3, fr = lane & 15, fq = lane >> 4;
    const int K = g.K, nt = K / BK;
    unsigned voffA[2], voffB[2];
#pragma unroll
    for (int i = 0; i < 2; ++i) { int R, C; stage_rc(tid * 16 + i * 8192, R, C); const int Rb = Epi::PERM ? ((R & ~31) + perm32(R & 31)) : R;
        voffA[i] = (unsigned)(R * g.lda + C) * 2u; voffB[i] = (unsigned)(Rb * g.ldb + C) * 2u; }
    const size_t kstep = (size_t)(BK * 2);
    const size_t hstepA = (size_t)HALF * g.lda * 2, hstepB = (size_t)HALF * g.ldb * 2;
    const size_t tstepA = 2 * hstepA, tstepB = 2 * hstepB;
    const unsigned ldsw = (unsigned)wid * 1024u;
    const int aoff = lds_byte(wr * 64 + fr, fq * 8), boff = lds_byte(wc * 32 + fr, fq * 8);
#define PG8_SA(b, h) (((b) * 2 + (h)) * HTB)
#define PG8_SB(b, h) ((4 + (b) * 2 + (h)) * HTB)
#define PG8_STAGE(bufoff, gbase, voff) do { _Pragma("unroll") for (int _i = 0; _i < 2; ++_i) \
        __builtin_amdgcn_global_load_lds((const GAS unsigned*)((const GAS char*)(gbase) + (voff)[_i]), (LAS unsigned*)(lds + (bufoff) + ldsw + _i * 8192), 16, 0, 0); } while (0)
#define PG8_LDA(dst, b, h) do { _Pragma("unroll") for (int m = 0; m < 4; ++m) _Pragma("unroll") for (int k = 0; k < 2; ++k) dst[m][k] = *(const LAS bf16x8*)(lds + PG8_SA(b, h) + aoff + m * 2048 + k * 1024); } while (0)
#define PG8_LDB(dst, b, h) do { _Pragma("unroll") for (int n = 0; n < 2; ++n) _Pragma("unroll") for (int k = 0; k < 2; ++k) dst[n][k] = *(const LAS bf16x8*)(lds + PG8_SB(b, h) + boff + n * 2048 + k * 1024); } while (0)
#define PG8_MMA(ai, bj, At, Bt) do { __builtin_amdgcn_s_setprio(1); _Pragma("unroll") for (int m = 0; m < 4; ++m) _Pragma("unroll") for (int n = 0; n < 2; ++n) _Pragma("unroll") for (int k = 0; k < 2; ++k) \
        acc[ai][bj][m][n] = __builtin_amdgcn_mfma_f32_16x16x32_bf16(Bt[n][k], At[m][k], acc[ai][bj][m][n], 0, 0, 0); __builtin_amdgcn_s_setprio(0); } while (0)
#define PG8_WAIT_V(n) asm volatile("s_waitcnt vmcnt(" #n ")" ::: "memory")
#define PG8_WAIT_L(n) asm volatile("s_waitcnt lgkmcnt(" #n ")" ::: "memory")
#define PG8_BAR __builtin_amdgcn_s_barrier()
#define PG8_SCHED __builtin_amdgcn_sched_barrier(0)
    Unit cur, nxt; int ui = 0;
    if (!S.next(0, cur)) return;
    f32x4 acc[2][2][4][2];
#pragma unroll
    for (int a = 0; a < 2; ++a)
#pragma unroll
        for (int b = 0; b < 2; ++b)
#pragma unroll
            for (int m = 0; m < 4; ++m)
#pragma unroll
                for (int n = 0; n < 2; ++n) acc[a][b][m][n] = (f32x4){0.f, 0.f, 0.f, 0.f};
    bf16x8 At[4][2], B0[2][2], B1[2][2];
    const GAS char* cA = (const GAS char*)g.A + (size_t)cur.pm * tstepA + cur.aoff; const GAS char* cB = (const GAS char*)g.Bt + (size_t)cur.pn * tstepB;
    PG8_STAGE(PG8_SB(0, 0), cB, voffB); PG8_STAGE(PG8_SB(0, 1), cB + hstepB, voffB); PG8_STAGE(PG8_SA(0, 0), cA, voffA); PG8_STAGE(PG8_SA(0, 1), cA + hstepA, voffA);
    if (wr == 1) PG8_BAR;
    PG8_WAIT_V(2); PG8_BAR;
    PG8_STAGE(PG8_SB(1, 0), cB + kstep, voffB); PG8_STAGE(PG8_SA(1, 0), cA + kstep, voffA); PG8_STAGE(PG8_SB(1, 1), cB + hstepB + kstep, voffB);
    PG8_WAIT_V(6); PG8_BAR;
    for (;;) {
        const bool has_next = S.next(ui + 1, nxt);
        const GAS char* nA = has_next ? (const GAS char*)g.A + (size_t)nxt.pm * tstepA + nxt.aoff : cA; const GAS char* nB = has_next ? (const GAS char*)g.Bt + (size_t)nxt.pn * tstepB : cB;
#pragma unroll 1
        for (int t = 0; t < nt; t += 2) {
            const bool last = (t == nt - 2);
            const GAS char* a1 = cA + (size_t)(t + 1) * kstep;
            const GAS char* a2 = last ? nA : cA + (size_t)(t + 2) * kstep; const GAS char* b2 = last ? nB : cB + (size_t)(t + 2) * kstep;
            const GAS char* a3 = a2 + kstep; const GAS char* b3 = b2 + kstep;
            PG8_LDB(B0, 0, 0); PG8_LDB(B1, 0, 1); PG8_SCHED; PG8_LDA(At, 0, 0); PG8_STAGE(PG8_SA(1, 1), a1 + hstepA, voffA);
            PG8_WAIT_V(8); PG8_WAIT_L(0); PG8_BAR; PG8_MMA(0, 0, At, B0); PG8_MMA(0, 1, At, B1); PG8_BAR; PG8_SCHED;
            PG8_LDA(At, 0, 1); PG8_STAGE(PG8_SB(0, 0), b2, voffB); PG8_STAGE(PG8_SB(0, 1), b2 + hstepB, voffB); PG8_STAGE(PG8_SA(0, 0), a2, voffA);
            PG8_WAIT_V(8); PG8_WAIT_L(0); PG8_BAR; PG8_MMA(1, 0, At, B0); PG8_MMA(1, 1, At, B1); PG8_BAR; PG8_SCHED;
            PG8_LDB(B0, 1, 0); PG8_LDB(B1, 1, 1); PG8_SCHED; PG8_LDA(At, 1, 0); PG8_STAGE(PG8_SA(0, 1), a2 + hstepA, voffA);
            PG8_WAIT_V(8); PG8_WAIT_L(0); PG8_BAR; PG8_MMA(0, 0, At, B0); PG8_MMA(0, 1, At, B1); PG8_BAR; PG8_SCHED;
            PG8_LDA(At, 1, 1); PG8_STAGE(PG8_SB(1, 0), b3, voffB); PG8_STAGE(PG8_SB(1, 1), b3 + hstepB, voffB); PG8_STAGE(PG8_SA(1, 0), a3, voffA);
            PG8_WAIT_V(8); PG8_WAIT_L(0); PG8_BAR; PG8_MMA(1, 0, At, B0); PG8_MMA(1, 1, At, B1); PG8_BAR; PG8_SCHED;
        }
        if (wr == 0) PG8_BAR;
        E(acc, cur, wr, wc, fr, fq);
        if (!has_next) break;
        if constexpr (!Epi::KEEP) {
#pragma unroll
        for (int a = 0; a < 2; ++a)
#pragma unroll
            for (int b = 0; b < 2; ++b)
#pragma unroll
                for (int m = 0; m < 4; ++m)
#pragma unroll
                    for (int n = 0; n < 2; ++n) acc[a][b][m][n] = (f32x4){0.f, 0.f, 0.f, 0.f};
        }
        cur = nxt; cA = nA; cB = nB; ++ui;
        if (wr == 1) PG8_BAR;
    }
    PG8_WAIT_V(0);
    PG8_BAR;
#undef PG8_SA
#undef PG8_SB
#undef PG8_STAGE
#undef PG8_LDA
#undef PG8_LDB
#undef PG8_MMA
#undef PG8_WAIT_V
#undef PG8_WAIT_L
#undef PG8_BAR
#undef PG8_SCHED
}

typedef f32x4 AccT[2][2][4][2];

struct EpiGemm1 {
    static constexpr bool PERM = true, KEEP = false;
    GAS bf16* gates; GAS bf16* hm;
    __device__ __forceinline__ void operator()(AccT& acc, const Unit& u, int wr, int wc, int fr, int fq) const {
        int ln; { ln = lane_id_opaque(); fr = ln & 15; fq = ln >> 4; }
        const int row0 = u.pm * BM + wr * 64 + fr; const bool isg = u.pn < 32;
        if (isg) {
            const int pnE = u.pn >> 2, bjE = (u.pn >> 1) & 1, wcE = 2 * (u.pn & 1) + (wc >> 1), fqE = 2 * (wc & 1) + (fq >> 1);
            GAS bf16* tb = gates + (size_t)((u.pm * 8 + pnE) * 4) * 65536 + (fr + 16 * fqE) * 8 + 4 * (fq & 1);
#pragma unroll
            for (int ai = 0; ai < 2; ++ai)
#pragma unroll
                for (int m = 0; m < 4; ++m) { GAS bf16* rowp = tb + ((((ai * 2 + wr) * 4 + m) * 2 + bjE) * 4 + wcE) * 512; float r[4][4];
#pragma unroll
                    for (int j = 0; j < 4; ++j) { float dn[4];
#pragma unroll
                        for (int i = 0; i < 4; ++i) dn[i] = fminf(1.f + fast_exp2(-LOG2E * acc[ai][i >> 1][m][i & 1][j]), 1e4f);
#pragma unroll
                        for (int i = 0; i < 4; ++i) r[i][j] = fast_rcp(dn[i]) * (i < 3 ? dn[(i + 1) & 3] : 1.0f); }
#pragma unroll
                    for (int i = 0; i < 4; ++i) *(GAS u32x2*)(rowp + i * 65536) = (u32x2){pk2(r[i][0], r[i][1]), pk2(r[i][2], r[i][3])}; }
        } else {
            const int col0 = (u.pn - 32) * BM + wc * 32 + 8 * fq;
#pragma unroll
            for (int ai = 0; ai < 2; ++ai)
#pragma unroll
                for (int m = 0; m < 4; ++m) { GAS bf16* rowp = hm + (size_t)(row0 + ai * HALF + m * 16) * HM_LD + col0;
#pragma unroll
                    for (int bj = 0; bj < 2; ++bj) { const f32x4 v0 = acc[ai][bj][m][0], v1 = acc[ai][bj][m][1];
                        u32x4 w; w.x = pk2(v0[0], v0[1]); w.y = pk2(v0[2], v0[3]); w.z = pk2(v1[0], v1[1]); w.w = pk2(v1[2], v1[3]);
                        *(GAS u32x4*)(rowp + bj * HALF) = w; } }
        }
    }
};

struct EpiQ {
    static constexpr bool PERM = true, KEEP = false;
    GAS bf16* q; const GAS float* rs; const GAS float* cosb; const GAS float* sinb;
    __device__ __forceinline__ void operator()(AccT& acc, const Unit& u, int wr, int wc, int fr, int fq) const {
        { const int ln = lane_id_opaque(); fr = ln & 15; fq = ln >> 4; }
        const int row0 = u.pm * BM + wr * 64 + fr; const float qs = 0.07216878364870322f * LOG2E;
        float sc[2][4];
#pragma unroll
        for (int ai = 0; ai < 2; ++ai)
#pragma unroll
            for (int m = 0; m < 4; ++m) sc[ai][m] = rs[2 * (row0 + ai * HALF + m * 16)] * qs;
#pragma unroll
        for (int bj = 0; bj < 2; ++bj) { const int c0 = u.pn * BM + bj * HALF + wc * 32 + 8 * fq; const int within = c0 % 192; const bool rope = within >= 128; const int j0 = rope ? (within - 128) >> 1 : 0;
#pragma unroll
            for (int am = 0; am < 2; ++am) { f32x4 cs[4], sn[4];
                if (rope) {
#pragma unroll
                    for (int m = 0; m < 4; ++m) { const int pos = (row0 + am * HALF + m * 16) & (SEQ - 1); cs[m] = *(const GAS f32x4*)(cosb + pos * 32 + j0); sn[m] = *(const GAS f32x4*)(sinb + pos * 32 + j0); } }
#pragma unroll
                for (int m = 0; m < 4; ++m) { const int ai = am; const int row = row0 + ai * HALF + m * 16;
                    f32x4 v0 = acc[ai][bj][m][0] * sc[ai][m], v1 = acc[ai][bj][m][1] * sc[ai][m];
                    if (rope) { f32x4 o0, o1;
                        o0[0] = v0[0] * cs[m][0] - v0[1] * sn[m][0]; o0[1] = v0[1] * cs[m][0] + v0[0] * sn[m][0];
                        o0[2] = v0[2] * cs[m][1] - v0[3] * sn[m][1]; o0[3] = v0[3] * cs[m][1] + v0[2] * sn[m][1];
                        o1[0] = v1[0] * cs[m][2] - v1[1] * sn[m][2]; o1[1] = v1[1] * cs[m][2] + v1[0] * sn[m][2];
                        o1[2] = v1[2] * cs[m][3] - v1[3] * sn[m][3]; o1[3] = v1[3] * cs[m][3] + v1[2] * sn[m][3];
                        v0 = o0; v1 = o1; }
                    u32x4 w; w.x = pk2(v0[0], v0[1]); w.y = pk2(v0[2], v0[3]); w.z = pk2(v1[0], v1[1]); w.w = pk2(v1[2], v1[3]);
                    *(GAS u32x4*)(q + (size_t)row * 768 + c0) = w; } } }
    }
};

struct EpiKV {
    static constexpr bool PERM = true, KEEP = false;
    GAS bf16* kn; GAS bf16* vt; const GAS float* rs;
    __device__ __forceinline__ void operator()(AccT& acc, const Unit& u, int wr, int wc, int fr, int fq) const {
        { const int ln = lane_id_opaque(); fr = ln & 15; fq = ln >> 4; }
        const int row0 = u.pm * BM + wr * 64 + fr;
        float sc[2][4];
        { const GAS float* rp = rs + 2 * row0 + 1;
#pragma unroll
        for (int ai = 0; ai < 2; ++ai)
#pragma unroll
            for (int m = 0; m < 4; ++m) sc[ai][m] = rp[2 * (ai * HALF + m * 16)]; }
        if (u.pn < 2) {
#pragma unroll
            for (int ai = 0; ai < 2; ++ai)
#pragma unroll
                for (int m = 0; m < 4; ++m) { const int row = row0 + ai * HALF + m * 16;
#pragma unroll
                    for (int bj = 0; bj < 2; ++bj) { const f32x4 v0 = acc[ai][bj][m][0] * sc[ai][m], v1 = acc[ai][bj][m][1] * sc[ai][m]; const int c0 = u.pn * BM + bj * HALF + wc * 32 + 8 * fq;
                        u32x4 w; w.x = pk2(v0[0], v0[1]); w.y = pk2(v0[2], v0[3]); w.z = pk2(v1[0], v1[1]); w.w = pk2(v1[2], v1[3]);
                        *(GAS u32x4*)(kn + (size_t)row * 512 + c0) = w; } }
        } else {
            const int b = row0 >> 12, s0 = row0 & (SEQ - 1);
#pragma unroll
            for (int bj = 0; bj < 2; ++bj) { const int head = 2 * (u.pn - 2) + bj;
#pragma unroll
                for (int n = 0; n < 2; ++n)
#pragma unroll
                    for (int j = 0; j < 4; ++j) { const int dv = wc * 32 + 8 * fq + 4 * n + j;
                        GAS bf16* p = vt + ((size_t)((b * 4 + head) * 128 + dv)) * SEQ + s0;
#pragma unroll
                        for (int ai = 0; ai < 2; ++ai)
#pragma unroll
                            for (int m = 0; m < 4; ++m) p[ai * HALF + m * 16] = f2bf(acc[ai][bj][m][n][j] * sc[ai][m]); } }
        }
    }
};

struct EpiPool {
    static constexpr bool PERM = true, KEEP = false;
    GAS bf16* br; const GAS float* scale;
    __device__ __forceinline__ void operator()(AccT& acc, const Unit& u, int wr, int wc, int fr, int fq) const {
        { const int ln = lane_id_opaque(); fr = ln & 15; fq = ln >> 4; }
        const int row0 = u.pm * BM + wr * 64 + fr;
#pragma unroll
        for (int bj = 0; bj < 2; ++bj) { const int c0 = u.pn * BM + bj * HALF + wc * 32 + 8 * fq;
            const f32x4 s0 = *(const GAS f32x4*)(scale + c0), s1 = *(const GAS f32x4*)(scale + c0 + 4);
#pragma unroll
            for (int ai = 0; ai < 2; ++ai)
#pragma unroll
                for (int m = 0; m < 4; ++m) { const int row = row0 + ai * HALF + m * 16; const f32x4 v0 = acc[ai][bj][m][0] * s0, v1 = acc[ai][bj][m][1] * s1;
                    u32x4 w; w.x = pk2(v0[0], v0[1]); w.y = pk2(v0[2], v0[3]); w.z = pk2(v1[0], v1[1]); w.w = pk2(v1[2], v1[3]);
                    *(GAS u32x4*)(br + (size_t)row * D + 1536 + c0) = w; } }
    }
};

struct EpiMerge {
    static constexpr bool PERM = true, KEEP = true;
    const GAS bf16* gates; GAS bf16* mg;
    __device__ __forceinline__ void operator()(AccT& acc, const Unit& u, int wr, int wc, int fr, int fq) const {
        int ln; { ln = lane_id_opaque(); fr = ln & 15; fq = ln >> 4; }
        const int br = u.pn >> 3, pn = u.pn & 7; const int row0 = u.pm * BM + wr * 64 + fr; const int c0 = pn * BM + wc * 32 + 8 * fq;
        const GAS bf16* gp = gates + (size_t)((u.pm * 8 + pn) * 4 + br) * 65536 + (wr * 32 + wc) * 512 + ln * 8;
#pragma unroll
        for (int am = 0; am < 4; ++am) { const int ai = am >> 1, mh = (am & 1) * 2; u32x4 gw[2][2];
#pragma unroll
            for (int mm = 0; mm < 2; ++mm)
#pragma unroll
                for (int bj = 0; bj < 2; ++bj) gw[mm][bj] = __builtin_nontemporal_load((const GAS u32x4*)(gp + (((ai * 2) * 4 + (mh + mm)) * 2 + bj) * 4 * 512));
            if (br < 3) {
#pragma unroll
                for (int mm = 0; mm < 2; ++mm)
#pragma unroll
                    for (int bj = 0; bj < 2; ++bj) { acc[ai][bj][mh + mm][0] *= ld4bf_lo(gw[mm][bj]); acc[ai][bj][mh + mm][1] *= ld4bf_hi(gw[mm][bj]); }
            } else {
#pragma unroll
                for (int mm = 0; mm < 2; ++mm) { const int m = mh + mm; const int row = row0 + ai * HALF + m * 16;
#pragma unroll
                    for (int bj = 0; bj < 2; ++bj) { const f32x4 v0 = acc[ai][bj][m][0] * ld4bf_lo(gw[mm][bj]), v1 = acc[ai][bj][m][1] * ld4bf_hi(gw[mm][bj]);
                        u32x4 w; w.x = pk2(v0[0], v0[1]); w.y = pk2(v0[2], v0[3]); w.z = pk2(v1[0], v1[1]); w.w = pk2(v1[2], v1[3]);
                        *(GAS u32x4*)(mg + (size_t)row * D + c0 + bj * HALF) = w;
                        acc[ai][bj][m][0] = (f32x4){0.f, 0.f, 0.f, 0.f}; acc[ai][bj][m][1] = (f32x4){0.f, 0.f, 0.f, 0.f}; } }
            }
            asm volatile("" ::: "memory"); }
    }
};

struct EpiOut {
    static constexpr bool PERM = true, KEEP = false;
    const GAS float* x; GAS float* y; GAS bf16* yb; GAS float* st;
    __device__ __forceinline__ void operator()(AccT& acc, const Unit& u, int wr, int wc, int fr, int fq) const {
        { const int ln = lane_id_opaque(); fr = ln & 15; fq = ln >> 4; }
        const int row0 = u.pm * BM + wr * 64 + fr, col0 = u.pn * BM + wc * 32 + 8 * fq;
#pragma unroll
        for (int am = 0; am < 4; ++am) { const int ai = am >> 1, mh = (am & 1) * 2; f32x4 xv[2][2][2];
#pragma unroll
            for (int mm = 0; mm < 2; ++mm)
#pragma unroll
                for (int bj = 0; bj < 2; ++bj) { const size_t ro = (size_t)(row0 + ai * HALF + (mh + mm) * 16) * D + col0 + bj * HALF; xv[mm][bj][0] = __builtin_nontemporal_load((const GAS f32x4*)(x + ro)); xv[mm][bj][1] = __builtin_nontemporal_load((const GAS f32x4*)(x + ro + 4)); }
#pragma unroll
            for (int mm = 0; mm < 2; ++mm) { const int m = mh + mm; const int row = row0 + ai * HALF + m * 16; const size_t ro = (size_t)row * D + col0; float s1 = 0.f, s2 = 0.f;
#pragma unroll
                for (int bj = 0; bj < 2; ++bj) {
                    const f32x4 v0 = xv[mm][bj][0] * DN_ALPHA + acc[ai][bj][m][0], v1 = xv[mm][bj][1] * DN_ALPHA + acc[ai][bj][m][1];
                    *(GAS f32x4*)(y + ro + bj * HALF) = v0; *(GAS f32x4*)(y + ro + bj * HALF + 4) = v1;
                    *(GAS u32x4*)(yb + ro + bj * HALF) = (u32x4){pk2(v0[0], v0[1]), pk2(v0[2], v0[3]), pk2(v1[0], v1[1]), pk2(v1[2], v1[3])};
                    s1 += (v0[0] + v0[1]) + (v0[2] + v0[3]) + (v1[0] + v1[1]) + (v1[2] + v1[3]);
                    s2 += (v0[0] * v0[0] + v0[1] * v0[1]) + (v0[2] * v0[2] + v0[3] * v0[3]) + (v1[0] * v1[0] + v1[1] * v1[1]) + (v1[2] * v1[2] + v1[3] * v1[3]); }
                s1 += __shfl_xor(s1, 16); s2 += __shfl_xor(s2, 16); s1 += __shfl_xor(s1, 32); s2 += __shfl_xor(s2, 32);
                if (fq == 0) { __hip_atomic_fetch_add(st + 2 * row, s1, __ATOMIC_RELAXED, __HIP_MEMORY_SCOPE_AGENT); __hip_atomic_fetch_add(st + 2 * row + 1, s2, __ATOMIC_RELAXED, __HIP_MEMORY_SCOPE_AGENT); } }
            asm volatile("" ::: "memory"); }
    }
};

struct EpiScore {
    static constexpr bool PERM = true, KEEP = false;
    GAS bf16* c; const GAS float* st; const GAS float* cs; const GAS float* bw;
    __device__ __forceinline__ void operator()(AccT& acc, const Unit& u, int wr, int wc, int fr, int fq) const {
        { const int ln = lane_id_opaque(); fr = ln & 15; fq = ln >> 4; }
        const int row0 = u.pm * BM + wr * 64 + fr, col0 = u.pn * BM + wc * 32 + 8 * fq;
        f32x4 cv[2][2], bv[2][2];
#pragma unroll
        for (int bj = 0; bj < 2; ++bj)
#pragma unroll
            for (int n = 0; n < 2; ++n) { cv[bj][n] = *(const GAS f32x4*)(cs + col0 + bj * HALF + n * 4); bv[bj][n] = *(const GAS f32x4*)(bw + col0 + bj * HALF + n * 4); }
        float sa[2][4], sb[2][4];
#pragma unroll
        for (int ai = 0; ai < 2; ++ai)
#pragma unroll
            for (int m = 0; m < 4; ++m) { const int row = row0 + ai * HALF + m * 16; sa[ai][m] = st[2 * row]; sb[ai][m] = st[2 * row + 1]; }
#pragma unroll
        for (int ai = 0; ai < 2; ++ai)
#pragma unroll
            for (int m = 0; m < 4; ++m) { const int row = row0 + ai * HALF + m * 16; const size_t ro = (size_t)row * D + col0;
                const float mu = sa[ai][m] * (1.0f / D), var = sb[ai][m] * (1.0f / D) - mu * mu, rs = 1.0f / sqrtf(var + NORM_EPS);
#pragma unroll
                for (int bj = 0; bj < 2; ++bj) { const f32x4 v0 = (acc[ai][bj][m][0] - mu * cv[bj][0]) * rs + bv[bj][0], v1 = (acc[ai][bj][m][1] - mu * cv[bj][1]) * rs + bv[bj][1];
                    *(GAS u32x4*)(c + ro + bj * HALF) = (u32x4){pk2(v0[0], v0[1]), pk2(v0[2], v0[3]), pk2(v1[0], v1[1]), pk2(v1[2], v1[3])}; } }
    }
};
}
#define XB_TMO      128
#define XB_XCNT(j)  (256  + 64 * (j))
#define XB_XSUB(j)  (1280 + 64 * (j))
#define XB_XGEN(j)  (2304 + 64 * (j))
#define XB_TOP      3328
#define XB_TOPGEN   3392
#define XCD_BAR_WORDS 3456
#define XB_SPIN_CAP (1u << 20)

__device__ __forceinline__ unsigned xb_ld(unsigned* p)              { return __hip_atomic_load(p, __ATOMIC_RELAXED, __HIP_MEMORY_SCOPE_AGENT); }
__device__ __forceinline__ unsigned xb_add(unsigned* p, unsigned v) { return __hip_atomic_fetch_add(p, v, __ATOMIC_RELAXED, __HIP_MEMORY_SCOPE_AGENT); }
__device__ __forceinline__ unsigned xb_xcc_id() { return (unsigned)__builtin_amdgcn_s_getreg((3 << 11) | 20) & 0xFu; }
#define XB_SPIN(cond, bar) do { unsigned _sp = 0; while (cond) { __builtin_amdgcn_s_sleep(1); \
    if ((++_sp & 255u) == 0u) { if (xb_ld(&(bar)[XB_TMO])) break; if (_sp > XB_SPIN_CAP) { atomicAdd(&(bar)[XB_TMO], 1u); break; } } } } while (0)

struct XcdBarrier {
    unsigned* bar; unsigned x;
    volatile LAS unsigned* st;
    int wave;
};
#define XB_LEADER(b) ((b).wave == 0 && lane_id_opaque() == 0)
__device__ __forceinline__ XcdBarrier xcd_barrier_post(unsigned* bar, volatile LAS unsigned* st, int wave) {
    XcdBarrier b; b.bar = bar; b.x = xb_xcc_id(); b.st = st; b.wave = wave;
    if (XB_LEADER(b)) (void)xb_add(&bar[XB_XCNT(b.x)], 1u);
    return b;
}
__device__ __forceinline__ void xcd_barrier_complete(unsigned* bar, unsigned x, unsigned& nloc, unsigned& nx) {
    const unsigned G = gridDim.x * gridDim.y * gridDim.z;
    unsigned sum, cnt, mine, sp = 0u;
    for (;;) {
        sum = 0u; cnt = 0u; mine = 0u;
#pragma unroll
        for (unsigned j = 0; j < 16; ++j) { const unsigned c = xb_ld(&bar[XB_XCNT(j)]); sum += c; cnt += (c > 0u) ? 1u : 0u; mine = (j == x) ? c : mine; }
        if (sum == G) break;
        __builtin_amdgcn_s_sleep(1);
        if ((++sp & 255u) == 0u) { if (xb_ld(&bar[XB_TMO])) break; if (sp > XB_SPIN_CAP) { atomicAdd(&bar[XB_TMO], 1u); break; } }
    }
    nloc = mine > 0u ? mine : 1u; nx = cnt > 0u ? cnt : 1u;
}
__device__ __forceinline__ void xcd_barrier(const XcdBarrier& b) {
    asm volatile("s_waitcnt vmcnt(0)" ::: "memory");
    __syncthreads();
    if (XB_LEADER(b)) {
        unsigned* bar = b.bar;
        __builtin_amdgcn_s_waitcnt(0);
        unsigned nloc = b.st[0], nx = b.st[1];
        if (nloc == 0u) { xcd_barrier_complete(bar, b.x, nloc, nx); b.st[0] = nloc; b.st[1] = nx; }
        const unsigned old = xb_add(&bar[XB_XSUB(b.x)], 1u);
        const unsigned gen = old / nloc;
        if (old + 1u == (gen + 1u) * nloc) {
            __builtin_amdgcn_fence(__ATOMIC_RELEASE, "agent");
            asm volatile("s_waitcnt vmcnt(0)" ::: "memory");
            const unsigned og = xb_add(&bar[XB_TOP], 1u);
            const unsigned tg = og / nx;
            if (og + 1u == (tg + 1u) * nx) xb_add(&bar[XB_TOPGEN], 1u);
            else XB_SPIN(xb_ld(&bar[XB_TOPGEN]) == tg, bar);
            __builtin_amdgcn_fence(__ATOMIC_ACQUIRE, "agent");
            xb_add(&bar[XB_XGEN(b.x)], 1u);
            asm volatile("s_waitcnt vmcnt(0)" ::: "memory");
        } else {
            XB_SPIN(xb_ld(&bar[XB_XGEN(b.x)]) == gen, bar);
            __builtin_amdgcn_fence(__ATOMIC_ACQUIRE, "agent");
            asm volatile("s_waitcnt vmcnt(0)" ::: "memory");
        }
    }
    __syncthreads();
}

struct Args {
    const float* in[20]; float* out; unsigned char* ws; int ph_lo, ph_hi;
};
struct Frame {
    LAS unsigned char* lds;
    int tid, lane, wave, vcu, G;
    GAS unsigned char* ws;
};

template <class RowMap>
DI void transpose_item(const GAS float* W, int ldw, int k0, int n0, GAS bf16* WT, int ldk, int kdst0, const GAS float* kgain, const RowMap& rm, LAS float* scr, int lane) {
#pragma unroll
    for (int i = 0; i < 8; ++i) { const int kk = 8 * i + (lane >> 3), c4 = lane & 7; f32x4 v = *(const GAS f32x4*)(W + (size_t)(k0 + kk) * ldw + n0 + 4 * c4); if (kgain) v *= kgain[k0 + kk];
        LAS float* d = scr + kk * 33 + 4 * c4; d[0] = v[0]; d[1] = v[1]; d[2] = v[2]; d[3] = v[3]; }
    LDS_WAIT(); asm volatile("" ::: "memory");
    const int c = lane & 7;
#pragma unroll
    for (int j = 0; j < 4; ++j) { const int n = (lane >> 3) + 8 * j; const LAS float* s = scr + (8 * c) * 33 + n;
        u32x4 o; o.x = pk2(s[0 * 33], s[1 * 33]); o.y = pk2(s[2 * 33], s[3 * 33]); o.z = pk2(s[4 * 33], s[5 * 33]); o.w = pk2(s[6 * 33], s[7 * 33]);
        *(GAS u32x4*)(WT + (size_t)rm(n0 + n) * ldk + kdst0 + k0 + 8 * c) = o; }
    LDS_WAIT(); asm volatile("" ::: "memory");
}
struct RmIdent { int off; DI int operator()(int n) const { return n + off; } };
struct RmWin { DI int operator()(int n) const { if (n < NHM) return n + NGATE; const int g = n - NHM, i = g >> 11, d = g & 2047;
    return 256 * (d >> 6) + 128 * (i >> 1) + 32 * ((d & 63) >> 4) + 8 * ((d >> 2) & 3) + 4 * (i & 1) + (d & 3); } };
struct RmQup { DI int operator()(int n) const { const int h = n / 192, w = n % 192; if (w < 128) return n; const int r = w - 128; const int j = r & 31, e = r >> 5; return h * 192 + 128 + 2 * j + e; } };
struct RmKvup { DI int operator()(int n) const { const int h = n >> 8, e = (n >> 7) & 1, j = n & 127; return e * 512 + h * 128 + j; } };

DI void zero_row_bytes(GAS void* p, int nbytes, int lane) { GAS u32x4* q = (GAS u32x4*)p; for (int i = lane; i < nbytes / 16; i += 64) q[i] = (u32x4){0u, 0u, 0u, 0u}; }

DI void composite_item(const GAS float* wq, const GAS float* sk, const GAS float* g1, const GAS float* b1, GAS bf16* wpq, GAS float* cs, GAS float* bw, int hp, int dblk, int lane) {
    const int p = hp & 1, r = lane & 31, hb = lane >> 5, d0 = dblk * 32;
    f32x16 acc[4];
#pragma unroll
    for (int nb = 0; nb < 4; ++nb) acc[nb] = zero16();
#pragma unroll 2
    for (int s = 0; s < 8; ++s) {
        const GAS float* bp = wq + (size_t)(d0 + r) * D + hp * 128 + 16 * s + 8 * hb;
        const f32x4 b0 = *(const GAS f32x4*)bp, b1v = *(const GAS f32x4*)(bp + 4);
        u32x4 bwv = {pk2(b0[0], b0[1]), pk2(b0[2], b0[3]), pk2(b1v[0], b1v[1]), pk2(b1v[2], b1v[3])};
        const bf16x8 bf = __builtin_bit_cast(bf16x8, bwv);
#pragma unroll
        for (int nb = 0; nb < 4; ++nb) {
            const GAS float* ap = sk + ((size_t)p * 128 + 32 * nb + r) * 128 + 16 * s + 8 * hb;
            const f32x4 a0 = *(const GAS f32x4*)ap, a1 = *(const GAS f32x4*)(ap + 4);
            u32x4 aw = {pk2(a0[0], a0[1]), pk2(a0[2], a0[3]), pk2(a1[0], a1[1]), pk2(a1[2], a1[3])};
            acc[nb] = MFMA32(__builtin_bit_cast(bf16x8, aw), bf, acc[nb]);
        }
    }
    const float gd = g1[d0 + r], bd = b1[d0 + r];
#pragma unroll
    for (int nb = 0; nb < 4; ++nb)
#pragma unroll
        for (int i = 0; i < 16; ++i) { const int n = 32 * nb + crow(i, hb); const bf16 wb = f2bf(acc[nb][i] * gd); wpq[(size_t)(hp * 128 + n) * D + d0 + r] = wb;
            float c = bf2f(wb), b = acc[nb][i] * bd;
#pragma unroll
            for (int o = 1; o < 32; o <<= 1) { c += __shfl_xor(c, o); b += __shfl_xor(b, o); }
            if (r == 0) { __hip_atomic_fetch_add(cs + hp * 128 + n, c, __ATOMIC_RELAXED, __HIP_MEMORY_SCOPE_AGENT); __hip_atomic_fetch_add(bw + hp * 128 + n, b, __ATOMIC_RELAXED, __HIP_MEMORY_SCOPE_AGENT); } }
}

DI void p0_prologue(Frame& F, const Args& a) {
    LAS float* scr = (LAS float*)(F.lds + F.wave * 16384);
    const int gw = F.vcu * NWAVES + F.wave, NGW = F.G * NWAVES, lane = F.lane;
    unsigned GAS char* ws = F.ws;
    constexpr int I_WIN = (D / 64) * (IN_DIM / 32);
    constexpr int I_QUP = (512 / 64) * (768 / 32);
    constexpr int I_KVUP = (256 / 64) * (1024 / 32);
    constexpr int I_POOL = 4 * 2 * 4;
    constexpr int I_BR = 4 * (512 / 64) * (D / 32);
    constexpr int I_OUT = (D / 64) * (D / 32);
    constexpr int I_LAYER = I_WIN + I_QUP + I_KVUP + I_POOL + I_BR + I_OUT;
    for (int it = gw; it < DEPTH * I_LAYER; it += NGW) {
        const int l = it / I_LAYER; int r = it % I_LAYER;
        if (r < I_WIN) { const int nblk = IN_DIM / 32, kb = r / nblk, nb = r % nblk;
            transpose_item(((const GAS float*)a.in[1]) + (size_t)l * D * IN_DIM, IN_DIM, 64 * kb, 32 * nb, (GAS bf16*)(ws + WS_WIN + l * SZ_WIN), D, 0, nullptr, RmWin{}, scr, lane); continue; } r -= I_WIN;
        if (r < I_QUP) { const int nblk = 768 / 32, kb = r / nblk, nb = r % nblk;
            transpose_item(((const GAS float*)a.in[5]) + (size_t)l * 512 * 768, 768, 64 * kb, 32 * nb, (GAS bf16*)(ws + WS_WQUP + l * SZ_WQUP), 512, 0, ((const GAS float*)a.in[4]) + l * 512, RmQup{}, scr, lane); continue; } r -= I_QUP;
        if (r < I_KVUP) { const int nblk = 1024 / 32, kb = r / nblk, nb = r % nblk;
            transpose_item(((const GAS float*)a.in[7]) + (size_t)l * 256 * 1024, 1024, 64 * kb, 32 * nb, (GAS bf16*)(ws + WS_WKVUP + l * SZ_WKVUP), 256, 0, ((const GAS float*)a.in[6]) + l * 256, RmKvup{}, scr, lane); continue; } r -= I_KVUP;
        if (r < I_POOL) { const int g = r >> 3, kb = (r >> 2) & 1, nb = r & 3;
            transpose_item(((const GAS float*)a.in[8]) + ((size_t)l * 4 + g) * 128 * 128, 128, 64 * kb, 32 * nb, (GAS bf16*)(ws + WS_WPOOL + l * SZ_WPOOL), 512, g * 128, nullptr, RmIdent{g * 128}, scr, lane); continue; } r -= I_POOL;
        if (r < I_BR) { const int i = r / 512, rr = r % 512, nblk = D / 32, kb = rr / nblk, nb = rr % nblk;
            transpose_item(((const GAS float*)a.in[10]) + ((size_t)l * 4 + i) * 512 * D, D, 64 * kb, 32 * nb, (GAS bf16*)(ws + WS_WBR + l * SZ_WBR), 512, 0, nullptr, RmIdent{i * D}, scr, lane); continue; } r -= I_BR;
        { const int nblk = D / 32, kb = r / nblk, nb = r % nblk;
            transpose_item(((const GAS float*)a.in[11]) + (size_t)l * D * D, D, 64 * kb, 32 * nb, (GAS bf16*)(ws + WS_WOUT + l * SZ_WSQ), D, 0, nullptr, RmIdent{0}, scr, lane); }
    }
    for (int it = gw; it < DEPTH * (192 + 512); it += NGW) {
        const int l = it / 704, r = it % 704;
        if (r < 192) zero_row_bytes(ws + WS_WIN + l * SZ_WIN + (size_t)(IN_DIM + r) * D * 2, D * 2, lane);
        else { const int n = r - 192, g = n >> 7; GAS bf16* row = (GAS bf16*)(ws + WS_WPOOL + l * SZ_WPOOL) + (size_t)n * 512;
            for (int gb = 0; gb < 4; ++gb) if (gb != g && lane < 16) *(GAS u32x4*)(row + gb * 128 + lane * 8) = (u32x4){0u, 0u, 0u, 0u}; }
    }
    for (int it = gw; it < DEPTH * 16 * 64; it += NGW) {
        const int l = it >> 10, hp = (it >> 6) & 15, dblk = it & 63;
        composite_item(((const GAS float*)a.in[14]) + (size_t)l * D * D, ((const GAS float*)a.in[15]) + (size_t)l * 2 * 128 * 128, ((const GAS float*)a.in[12]) + l * D, ((const GAS float*)a.in[13]) + l * D,
                       (GAS bf16*)(ws + WS_WPQ + l * SZ_WSQ), (GAS float*)(ws + WS_CTL) + CW_CS + l * 2048, (GAS float*)(ws + WS_CTL) + CW_BW + l * 2048, hp, dblk, lane);
    }
    { GAS float* cosb = (GAS float*)(ws + WS_ROPE); GAS float* sinb = cosb + SEQ * 32;
      for (int i = gw * 64 + lane; i < SEQ * 32; i += NGW * 64) { const int pos = i >> 5, j = i & 31;
          const float inv = fast_exp2(-(float)j * 0.41524101186092029f);
          const float ang = (float)pos * inv; double rev = (double)ang * 0.15915494309189535; rev -= __builtin_rint(rev);
          cosb[i] = __builtin_amdgcn_cosf((float)rev); sinb[i] = __builtin_amdgcn_sinf((float)rev); } }
    { const size_t gt = (size_t)gw * 64 + lane, NT = (size_t)NGW * 64;
      { const GAS float* src = ((const GAS float*)a.in[0]); GAS bf16* dst = (GAS bf16*)(ws + WS_XB); const size_t n8 = (size_t)T * D / 8;
        for (size_t i = gt; i < n8; i += NT) { const f32x4 v0 = *(const GAS f32x4*)(src + i * 8), v1 = *(const GAS f32x4*)(src + i * 8 + 4);
            *(GAS u32x4*)(dst + i * 8) = (u32x4){pk2(v0[0], v0[1]), pk2(v0[2], v0[3]), pk2(v1[0], v1[1]), pk2(v1[2], v1[3])}; } }
#pragma unroll 1
      for (int tb = 0; tb < 2; ++tb) { const GAS float* src = (const GAS float*)a.in[16 + tb]; GAS unsigned char* dst = ws + (tb ? WS_TABV : WS_TABU); const size_t n32 = (size_t)DEPTH * NEXP * 64;
        const float scl = tb ? V_SCALE : U_SCALE;
        for (size_t i = gt; i < n32; i += NT) { const size_t row = i >> 6; const int ln = (int)(i & 63);
            f32x16 va, vb; const GAS float* sp = src + row * D + 4 * ln;
#pragma unroll
            for (int q = 0; q < 4; ++q) { const f32x4 x = __builtin_nontemporal_load((const GAS f32x4*)(sp + 256 * q)) * scl, y = __builtin_nontemporal_load((const GAS f32x4*)(sp + 256 * (q + 4))) * scl;
#pragma unroll
                for (int e = 0; e < 4; ++e) { va[4 * q + e] = x[e]; vb[4 * q + e] = y[e]; } }
            const u32x6 w = __builtin_amdgcn_cvt_scalef32_2xpk16_fp6_f32(va, vb, 1.0f);
            GAS unsigned char* rp = dst + row * ROWB;
            *(GAS u32x4*)(rp + 16 * ln) = (u32x4){w[0], w[1], w[2], w[3]}; *(GAS u32x2*)(rp + 1024 + 8 * ln) = (u32x2){w[4], w[5]}; } } }
}

DI void elem_chunk(Frame& F, int ch, const GAS bf16* hm, GAS bf16* br, GAS bf16* py, GAS bf16* kpe, GAS float* rs, GAS float* st, const GAS float* convw, const GAS float* cosb, const GAS float* sinb) {
    const int T0 = ch * 64, tid = F.tid, lane = F.lane;
    if (tid < 128) st[T0 * 2 + tid] = 0.f;
    const int t0 = T0 + 8 * F.wave, pos0 = t0 & (SEQ - 1);
    const u32x4 zz = {0u, 0u, 0u, 0u};
    { f32x4 w0[3], w1[3];
#pragma unroll
      for (int d = 0; d < 3; ++d) { w0[d] = *(const GAS f32x4*)(convw + d * 512 + 8 * lane); w1[d] = *(const GAS f32x4*)(convw + d * 512 + 8 * lane + 4); }
#pragma unroll 1
      for (int h = 0; h < 2; ++h) { const int tb = t0 + 4 * h;
          const GAS bf16* rp = hm + (size_t)(tb - 2) * HM_LD + 8 * lane;
          u32x4 uw[6], cw[6], bw[4];
#pragma unroll
          for (int k = 0; k < 6; ++k) { uw[k] = *(const GAS u32x4*)(rp + (size_t)k * HM_LD + C_CONVU); cw[k] = *(const GAS u32x4*)(rp + (size_t)k * HM_LD + C_CONVC); }
#pragma unroll
          for (int k = 0; k < 4; ++k) bw[k] = *(const GAS u32x4*)(rp + (size_t)(k + 2) * HM_LD + C_CONVB);
          f32x4 z0[6], z1[6];
#pragma unroll
          for (int k = 0; k < 6; ++k) { const bool ok = (pos0 + 4 * h - 2 + k) >= 0; const u32x4 a = ok ? uw[k] : zz, c = ok ? cw[k] : zz; z0[k] = ld4bf_lo(a) * ld4bf_lo(c); z1[k] = ld4bf_hi(a) * ld4bf_hi(c); }
#pragma unroll
          for (int k = 0; k < 4; ++k) { f32x4 y0 = w0[0] * z0[k] + w0[1] * z0[k + 1] + w0[2] * z0[k + 2], y1 = w1[0] * z1[k] + w1[1] * z1[k + 1] + w1[2] * z1[k + 2];
              y0 *= ld4bf_lo(bw[k]); y1 *= ld4bf_hi(bw[k]);
              *(GAS u32x4*)(br + (size_t)(tb + k) * D + 8 * lane) = (u32x4){pk2(y0[0], y0[1]), pk2(y0[2], y0[3]), pk2(y1[0], y1[1]), pk2(y1[2], y1[3])}; }
          asm volatile("" ::: "memory"); } }
    { const int g = lane >> 4, w = 2 << g;
#pragma unroll 1
      for (int h = 0; h < 2; ++h) { const int tb = t0 + 4 * h;
          const GAS bf16* rp = hm + (size_t)(tb - 15) * HM_LD + C_POOL + 8 * lane;
          u32x4 x[19];
#pragma unroll
          for (int k = 0; k < 19; ++k) x[k] = *(const GAS u32x4*)(rp + (size_t)k * HM_LD);
#pragma unroll
          for (int k = 0; k < 15; ++k) { const bool ok = (pos0 + 4 * h - 15 + k) >= 0; x[k] = ok ? x[k] : zz; }
#pragma unroll
          for (int jj = 0; jj < 4; ++jj) { const int pos = pos0 + 4 * h + jj; const int cnt = (pos + 1 < w) ? pos + 1 : w;
              const f32x4 u0 = ld4bf_lo(x[15 + jj]), u1 = ld4bf_hi(x[15 + jj]);
              f32x4 s0 = u0 + ld4bf_lo(x[14 + jj]), s1 = u1 + ld4bf_hi(x[14 + jj]);
              if (g >= 1) {
#pragma unroll
                  for (int d = 2; d < 4; ++d) { s0 += ld4bf_lo(x[15 + jj - d]); s1 += ld4bf_hi(x[15 + jj - d]); } }
              if (g >= 2) {
#pragma unroll
                  for (int d = 4; d < 8; ++d) { s0 += ld4bf_lo(x[15 + jj - d]); s1 += ld4bf_hi(x[15 + jj - d]); } }
              if (g >= 3) {
#pragma unroll
                  for (int d = 8; d < 16; ++d) { s0 += ld4bf_lo(x[15 + jj - d]); s1 += ld4bf_hi(x[15 + jj - d]); } }
              const float ic = 1.0f / (float)cnt; s0 = s0 * ic - u0; s1 = s1 * ic - u1;
              *(GAS u32x4*)(py + (size_t)(tb + jj) * 512 + 8 * lane) = (u32x4){pk2(s0[0], s0[1]), pk2(s0[2], s0[3]), pk2(s1[0], s1[1]), pk2(s1[2], s1[3])}; }
          asm volatile("" ::: "memory"); } }
    { u32x4 qw[8], kw[8]; float x1[8], x2[8], cc[8], ss[8];
#pragma unroll
      for (int k = 0; k < 8; ++k) { const int t = t0 + k; const GAS bf16* rp = hm + (size_t)t * HM_LD; const int pos = t & (SEQ - 1);
          qw[k] = *(const GAS u32x4*)(rp + C_CQ + 8 * lane); kw[k] = *(const GAS u32x4*)(rp + C_CKV + 8 * (lane & 31));
          x1[k] = bf2f(rp[C_KR + (lane & 31)]); x2[k] = bf2f(rp[C_KR + 32 + (lane & 31)]); cc[k] = cosb[pos * 32 + (lane & 31)]; ss[k] = sinb[pos * 32 + (lane & 31)]; }
#pragma unroll
      for (int k = 0; k < 8; ++k) { const int t = t0 + k; const f32x4 a = ld4bf_lo(qw[k]), b = ld4bf_hi(qw[k]), c = ld4bf_lo(kw[k]), d = ld4bf_hi(kw[k]);
          float sq = (a[0] * a[0] + a[1] * a[1]) + (a[2] * a[2] + a[3] * a[3]) + (b[0] * b[0] + b[1] * b[1]) + (b[2] * b[2] + b[3] * b[3]);
          float skv = (c[0] * c[0] + c[1] * c[1]) + (c[2] * c[2] + c[3] * c[3]) + (d[0] * d[0] + d[1] * d[1]) + (d[2] * d[2] + d[3] * d[3]);
          skv = (lane < 32) ? skv : 0.f;
          sq = wave_sum(sq); skv = wave_sum(skv);
          if (lane == 0) { rs[2 * t] = 1.0f / sqrtf(sq * (1.0f / 512.0f) + NORM_EPS); rs[2 * t + 1] = 1.0f / sqrtf(skv * (1.0f / 256.0f) + NORM_EPS); }
          if (lane < 32) *(GAS unsigned*)(kpe + (size_t)t * 64 + 2 * lane) = pk2(x1[k] * cc[k] - x2[k] * ss[k], x2[k] * cc[k] + x1[k] * ss[k]); } }
}

constexpr int SWA_KROW = 144, SWA_VROW = 520, SWA_VOFF = 256 * SWA_KROW;
DI void swa_unit(Frame& F, int unit, const GAS bf16* hm, GAS bf16* br, const GAS float* sinks) {
    const int kvh = unit & 1, nb = (unit >> 1) & 31, b = unit >> 6;
    const int t0 = b * SEQ + nb * 128, tid = F.tid, lane = F.lane, r = lane & 31, hb = lane >> 5;
    LAS unsigned char* lds = F.lds;
    const int g = F.wave >> 1, rh = F.wave & 1, head = kvh * 4 + g;
    bf16x8 qfa[2][4];
#pragma unroll
    for (int rbi = 0; rbi < 2; ++rbi)
#pragma unroll
        for (int s = 0; s < 4; ++s) qfa[rbi][s] = *(const GAS bf16x8*)(hm + (size_t)(t0 + 32 * (2 * rh + rbi) + r) * HM_LD + C_SWAQ + 64 * head + 16 * s + 8 * hb);
#pragma unroll
    for (int k = 0; k < 4; ++k) { const int id = tid + 512 * k, row = id >> 3, ch = id & 7; const bool ok = (nb > 0) || (row >= 128);
        u32x4 kw = {0u, 0u, 0u, 0u}, vw = kw;
        if (ok) { const GAS bf16* rp = hm + (size_t)(t0 - 128 + row) * HM_LD; kw = *(const GAS u32x4*)(rp + C_SWAK + 64 * kvh + 8 * ch); vw = *(const GAS u32x4*)(rp + C_SWAV + 64 * kvh + 8 * ch); }
        *(LAS u32x4*)(lds + row * SWA_KROW + ch * 16) = kw;
        LAS unsigned char* vp = lds + SWA_VOFF + (8 * ch) * SWA_VROW + row * 2;
        *(LAS bf16*)(vp + 0 * SWA_VROW) = (bf16)(vw.x & 0xffffu); *(LAS bf16*)(vp + 1 * SWA_VROW) = (bf16)(vw.x >> 16);
        *(LAS bf16*)(vp + 2 * SWA_VROW) = (bf16)(vw.y & 0xffffu); *(LAS bf16*)(vp + 3 * SWA_VROW) = (bf16)(vw.y >> 16);
        *(LAS bf16*)(vp + 4 * SWA_VROW) = (bf16)(vw.z & 0xffffu); *(LAS bf16*)(vp + 5 * SWA_VROW) = (bf16)(vw.z >> 16);
        *(LAS bf16*)(vp + 6 * SWA_VROW) = (bf16)(vw.w & 0xffffu); *(LAS bf16*)(vp + 7 * SWA_VROW) = (bf16)(vw.w >> 16); }
    __syncthreads();
    const float slope2 = fast_exp2(-(float)(head + 1)) * LOG2E, sink2 = sinks[head] * LOG2E, qk2 = 0.125f * LOG2E;
#pragma unroll 1
    for (int rbi = 0; rbi < 2; ++rbi) { const int rb = 2 * rh + rbi; const int qrow = t0 + 32 * rb + r;
        bf16x8 qf[4];
#pragma unroll
        for (int s = 0; s < 4; ++s) qf[s] = rbi ? qfa[1][s] : qfa[0][s];
        f32x16 S[5]; float mx = sink2;
#pragma unroll
        for (int tt = 0; tt < 5; ++tt) { const int tl = rb + tt; f32x16 acc = zero16();
#pragma unroll
            for (int s = 0; s < 4; ++s) { const bf16x8 kf = *(const LAS bf16x8*)(lds + (32 * tl + r) * SWA_KROW + (16 * s + 8 * hb) * 2); acc = MFMA32(kf, qf[s], acc); }
#pragma unroll
            for (int i = 0; i < 16; ++i) { const int kb = 32 * tl + crow(i, hb), dist = 128 + 32 * rb + r - kb; const bool ok = (dist >= 0) && (dist < 128) && ((nb > 0) || (kb >= 128));
                const float v = ok ? acc[i] * qk2 - slope2 * (float)dist : -1e30f; acc[i] = v; mx = fmaxf(mx, v); }
            S[tt] = acc; }
        mx = fmaxf(mx, __shfl_xor(mx, 32));
        float den = 0.f; bf16x8 pf[5][2];
#pragma unroll
        for (int tt = 0; tt < 5; ++tt) {
#pragma unroll
            for (int i = 0; i < 16; ++i) { const float p = fast_exp2(S[tt][i] - mx); S[tt][i] = p; den += p; }
#pragma unroll
            for (int s = 0; s < 2; ++s) { u32x4 w = {pk2(S[tt][8 * s], S[tt][8 * s + 1]), pk2(S[tt][8 * s + 2], S[tt][8 * s + 3]), pk2(S[tt][8 * s + 4], S[tt][8 * s + 5]), pk2(S[tt][8 * s + 6], S[tt][8 * s + 7])};
                pf[tt][s] = __builtin_bit_cast(bf16x8, w); } }
        den += __shfl_xor(den, 32); den += fast_exp2(sink2 - mx);
        const float inv = 1.0f / den;
        f32x16 O[2]; O[0] = zero16(); O[1] = zero16();
#pragma unroll
        for (int tt = 0; tt < 5; ++tt) { const int tl = rb + tt;
#pragma unroll
            for (int s = 0; s < 2; ++s)
#pragma unroll
                for (int dvb = 0; dvb < 2; ++dvb) { const LAS unsigned char* vp = lds + SWA_VOFF + (32 * dvb + r) * SWA_VROW + (32 * tl + 16 * s + 4 * hb) * 2;
                    const s16x4 lo = *(const LAS s16x4*)vp, hi = *(const LAS s16x4*)(vp + 16);
                    const bf16x8 vf = __builtin_shufflevector(lo, hi, 0, 1, 2, 3, 4, 5, 6, 7);
                    O[dvb] = MFMA32(vf, pf[tt][s], O[dvb]); } }
        GAS bf16* op = br + (size_t)qrow * D + 512 + 64 * head;
#pragma unroll
        for (int dvb = 0; dvb < 2; ++dvb)
#pragma unroll
            for (int ig = 0; ig < 4; ++ig) { const int dv0 = 32 * dvb + 8 * ig + 4 * hb;
#ifdef DBG_ZERO_SWA
                *(GAS u32x2*)(op + dv0) = (u32x2){0u, 0u}; }
#else
                *(GAS u32x2*)(op + dv0) = (u32x2){pk2(O[dvb][4 * ig] * inv, O[dvb][4 * ig + 1] * inv), pk2(O[dvb][4 * ig + 2] * inv, O[dvb][4 * ig + 3] * inv)}; }
#endif
    }
    __syncthreads();
}
constexpr int MLA_KROW = 400, MLA_VROW = 136, MLA_KBYTES = 64 * MLA_KROW, MLA_STG = MLA_KBYTES + 128 * MLA_VROW;
static_assert(2 * MLA_STG <= RING_BYTES, "MLA stage buffers");

DI void mla_unit(Frame& F, int b, int h, int qblk, const GAS bf16* q, const GAS bf16* kn, const GAS bf16* kpe, const GAS bf16* vt, GAS bf16* br) {
    const int tid = F.tid, lane = F.lane, r = lane & 31, hb = lane >> 5, rg = F.wave & 3, kp = F.wave >> 2;
    LAS unsigned char* lds = F.lds;
    const size_t rowb = (size_t)b * SEQ; const int q0 = qblk * 128;
    const int NS = 2 * (qblk + 1);
    const int kkey0 = tid >> 4, kc0 = tid & 15;
    const int rkey = tid >> 3, rc = tid & 7;
    const int vdv0 = tid >> 3, vc = tid & 7;
    const GAS unsigned char* knb = (const GAS unsigned char*)(kn + rowb * 512 + 128 * h);
    const GAS unsigned char* kpb = (const GAS unsigned char*)(kpe + rowb * 64);
    const GAS unsigned char* vtb = (const GAS unsigned char*)(vt + (size_t)((b * 4 + h) * 128) * SEQ);
    const unsigned knl = (unsigned)(kkey0 * 512 + 8 * kc0) * 2u, kpl = (unsigned)(rkey * 64 + 8 * rc) * 2u, vtl = (unsigned)(vdv0 * SEQ + 8 * vc) * 2u;
    u32x4 sk0A, sk1A, srA, sv0A, sv1A, sk0B, sk1B, srB, sv0B, sv1B;
#define MLA_LOAD(j, X) do { const unsigned ko = (unsigned)(64 * (j)); \
        sk0##X = *(const GAS u32x4*)(knb + (size_t)ko * 1024 + knl); sk1##X = *(const GAS u32x4*)(knb + (size_t)(ko + 32) * 1024 + knl); sr##X = *(const GAS u32x4*)(kpb + (size_t)ko * 128 + kpl); \
        sv0##X = *(const GAS u32x4*)(vtb + (size_t)ko * 2 + vtl); sv1##X = *(const GAS u32x4*)(vtb + (size_t)64 * SEQ * 2 + (size_t)ko * 2 + vtl); } while (0)
#define MLA_STORE(buf, X) do { LAS unsigned char* sb = lds + (buf) * MLA_STG; \
        *(LAS u32x4*)(sb + kkey0 * MLA_KROW + kc0 * 16) = sk0##X; *(LAS u32x4*)(sb + (kkey0 + 32) * MLA_KROW + kc0 * 16) = sk1##X; \
        *(LAS u32x4*)(sb + rkey * MLA_KROW + 256 + rc * 16) = sr##X; \
        LAS unsigned char* vb = sb + MLA_KBYTES + vdv0 * MLA_VROW + vc * 16; \
        *(LAS u32x2*)(vb) = (u32x2){sv0##X.x, sv0##X.y}; *(LAS u32x2*)(vb + 8) = (u32x2){sv0##X.z, sv0##X.w}; \
        *(LAS u32x2*)(vb + 64 * MLA_VROW) = (u32x2){sv1##X.x, sv1##X.y}; *(LAS u32x2*)(vb + 64 * MLA_VROW + 8) = (u32x2){sv1##X.z, sv1##X.w}; } while (0)
    MLA_LOAD(0, A); MLA_LOAD(1, B);
    bf16x8 qf[12];
    { const GAS bf16* qp = q + (rowb + q0 + 32 * rg + r) * 768 + 192 * h + 8 * hb;
#pragma unroll
      for (int s = 0; s < 12; ++s) qf[s] = *(const GAS bf16x8*)(qp + 16 * s); }
    MLA_STORE(0, A);
    __syncthreads();
    float m = -1e30f, lsum = 0.f; f32x16 O[4];
#pragma unroll
    for (int d = 0; d < 4; ++d) O[d] = zero16();
#define MLA_STEP(j, X, Y) do { \
        if ((j) + 1 < NS) MLA_STORE(((j) + 1) & 1, X);        \
        if ((j) + 2 < NS) MLA_LOAD((j) + 2, Y); \
        mla_compute(j); \
        __syncthreads(); } while (0)
    auto mla_compute = [&](int j) __attribute__((always_inline)) {
        const int taup = 2 * j + kp - 4 * qblk;
        if (taup <= rg) {
            const LAS unsigned char* sb = lds + (j & 1) * MLA_STG;
            f32x16 S = zero16();
            const LAS unsigned char* kpn = sb + (32 * kp + r) * MLA_KROW + hb * 16;
#pragma unroll
            for (int s = 0; s < 12; ++s) { const bf16x8 kf = *(const LAS bf16x8*)(kpn + s * 32); S = MFMA32(kf, qf[s], S); }
            if (taup == rg) {
#pragma unroll
                for (int i = 0; i < 16; ++i) if (crow(i, hb) > r) S[i] = -1e30f; }
            float mt = S[0];
#pragma unroll
            for (int i = 1; i < 16; ++i) mt = fmaxf(mt, S[i]);
            mt = fmaxf(mt, __shfl_xor(mt, 32));
            const float mn = fmaxf(m, mt);
            if (__any(mt > m)) {
                const float al = fast_exp2(m - mn); lsum *= al;
#pragma unroll
                for (int d = 0; d < 4; ++d) O[d] *= al; }
            m = mn;
            float ps = 0.f;
#pragma unroll
            for (int i = 0; i < 16; ++i) { const float p = fast_exp2(S[i] - mn); S[i] = p; ps += p; }
            lsum += ps;
            bf16x8 pf[2];
#pragma unroll
            for (int s = 0; s < 2; ++s) { u32x4 w = {pk2(S[8 * s], S[8 * s + 1]), pk2(S[8 * s + 2], S[8 * s + 3]), pk2(S[8 * s + 4], S[8 * s + 5]), pk2(S[8 * s + 6], S[8 * s + 7])}; pf[s] = __builtin_bit_cast(bf16x8, w); }
            const LAS unsigned char* vpn = sb + MLA_KBYTES + r * MLA_VROW + (32 * kp + 4 * hb) * 2;
#pragma unroll
            for (int d = 0; d < 4; ++d)
#pragma unroll
                for (int s = 0; s < 2; ++s) { const LAS unsigned char* vp = vpn + 32 * d * MLA_VROW + 32 * s;
                    const s16x4 lo = *(const LAS s16x4*)vp, hi = *(const LAS s16x4*)(vp + 16);
                    O[d] = MFMA32(__builtin_shufflevector(lo, hi, 0, 1, 2, 3, 4, 5, 6, 7), pf[s], O[d]); }
        }
    };
#pragma unroll 1
    for (int j = 0; j < NS; j += 2) { MLA_STEP(j, B, A); MLA_STEP(j + 1, A, B); }
#undef MLA_STEP
#undef MLA_LOAD
#undef MLA_STORE
    lsum += __shfl_xor(lsum, 32);
    LAS float* xo = (LAS float*)lds;
    LAS float* xm = (LAS float*)(lds + 65536);
    if (kp == 1) {
#pragma unroll
        for (int d = 0; d < 4; ++d)
#pragma unroll
            for (int i = 0; i < 16; ++i) xo[(rg * 64 + d * 16 + i) * 64 + lane] = O[d][i];
        xm[(rg * 2 + 0) * 64 + lane] = m; xm[(rg * 2 + 1) * 64 + lane] = lsum;
    }
    __syncthreads();
    if (kp == 0) {
        const float m1 = xm[(rg * 2 + 0) * 64 + lane], l1 = xm[(rg * 2 + 1) * 64 + lane];
        const float mn = fmaxf(m, m1), a0 = fast_exp2(m - mn), a1 = fast_exp2(m1 - mn);
        const float inv = 1.0f / (lsum * a0 + l1 * a1);
        const float c0 = a0 * inv, c1 = a1 * inv;
        GAS bf16* op = br + (rowb + q0 + 32 * rg + r) * D + 1024 + 128 * h;
#pragma unroll
        for (int d = 0; d < 4; ++d)
#pragma unroll
            for (int ig = 0; ig < 4; ++ig) { float v[4];
#pragma unroll
                for (int e = 0; e < 4; ++e) v[e] = O[d][4 * ig + e] * c0 + xo[(rg * 64 + d * 16 + 4 * ig + e) * 64 + lane] * c1;
                *(GAS u32x2*)(op + 32 * d + 8 * ig + 4 * hb) = (u32x2){pk2(v[0], v[1]), pk2(v[2], v[3])}; }
    }
    __syncthreads();
}

DI void mla_phase(Frame& F, const GAS bf16* q, const GAS bf16* kn, const GAS bf16* kpe, const GAS bf16* vt, GAS bf16* br) {
    for (int p = F.vcu; p < 256; p += F.G) { const int bh = p >> 4, i = p & 15;
        mla_unit(F, bh >> 2, bh & 3, 31 - i, q, kn, kpe, vt, br);
        mla_unit(F, bh >> 2, bh & 3, i, q, kn, kpe, vt, br); }
}
#ifdef PEER_NT
#define NTLD(p) __builtin_nontemporal_load(p)
#define NTST(p, v) __builtin_nontemporal_store((v), (p))
#else
#define NTLD(p) (*(p))
#define NTST(p, v) (*(p) = (v))
#endif
DI void ln1_phase(Frame& F, GAS float* y, GAS bf16* hbv, const GAS float* g, const GAS float* bta) {
    const int gw = F.vcu * NWAVES + F.wave, NGW = F.G * NWAVES, lane = F.lane;
    for (int row = gw; row < T; row += NGW) {
        GAS float* yr = y + (size_t)row * D + 4 * lane; f32x4 v[8]; float s = 0.f;
#pragma unroll
        for (int q = 0; q < 8; ++q) v[q] = *(const GAS f32x4*)(yr + 256 * q);
#pragma unroll
        for (int k = 0; k < 8; ++k) s += (v[k][0] + v[k][1]) + (v[k][2] + v[k][3]);
        const float mean = wave_sum(s) * (1.0f / D); float s2 = 0.f;
#pragma unroll
        for (int k = 0; k < 8; ++k) { v[k] = v[k] - mean; s2 += (v[k][0] * v[k][0] + v[k][1] * v[k][1]) + (v[k][2] * v[k][2] + v[k][3] * v[k][3]); }
        const float rstd = 1.0f / sqrtf(wave_sum(s2) * (1.0f / D) + NORM_EPS);
#pragma unroll
        for (int q = 0; q < 8; ++q) { const int c = 256 * q + 4 * lane;
            const f32x4 o0 = v[q] * rstd * *(const GAS f32x4*)(g + c) + *(const GAS f32x4*)(bta + c);
            *(GAS f32x4*)(yr + 256 * q) = o0;
            *(GAS u32x2*)(hbv + (size_t)row * D + c) = (u32x2){pk2(o0[0], o0[1]), pk2(o0[2], o0[3])}; }
    }
}

DI float gelu_erf(float a) { return 0.5f * a * (1.0f + erff(a * 0.70710678118654752f)); }

constexpr int PEER_G1OFF = 3072, PEER_B1OFF = 4096, PEER_G2OFF = 5120, PEER_B2OFF = 6144;
constexpr int PEER_WLDS = 16384;
DI void ins16k(float (&a)[16], float v) {
#pragma unroll
    for (int k = 15; k >= 1; --k) a[k] = __builtin_amdgcn_fmed3f(a[k - 1], a[k], v);
    a[0] = fmaxf(a[0], v);
}
DI void peer_topk4(LAS unsigned char* wl, const GAS bf16* sc, int tok0, int slot0) {
    const int lane = lane_id_opaque();
    LAS float* LV = (LAS float*)wl; LAS int* LI = (LAS int*)(wl + 4096);
    LAS int* EX = (LAS int*)(wl + 8192); LAS float* GT = (LAS float*)(wl + 12288);
    { float key[16];
#pragma unroll
      for (int k = 0; k < 16; ++k) key[k] = -3.0e38f;
      const int g4 = lane >> 4, c16 = lane & 15;
      const GAS bf16* sp = sc + (size_t)(tok0 + g4) * D + c16 * 8;
      u32x4 sw[16], sv[16];
#pragma unroll
      for (int k = 0; k < 16; ++k) sw[k] = __builtin_nontemporal_load((const GAS u32x4*)(sp + k * 128));
      LAS u32x4* TL = (LAS u32x4*)wl;
#pragma unroll
      for (int hf = 0; hf < 2; ++hf) {
#pragma unroll
          for (int k = 0; k < 8; ++k) TL[(g4 * 8 + k) * 16 + (c16 ^ k)] = sw[8 * hf + k];
          LDS_WAIT(); asm volatile("" ::: "memory");
          if ((c16 >> 3) == hf) {
#pragma unroll
              for (int n = 0; n < 16; ++n) sv[n] = TL[(g4 * 8 + (c16 & 7)) * 16 + (n ^ (c16 & 7))]; }
          LDS_WAIT(); asm volatile("" ::: "memory"); }
#pragma unroll
      for (int n = 0; n < 16; ++n)
#pragma unroll
          for (int e = 0; e < 4; ++e) { const unsigned w = sv[n][e]; const int i0 = 8 * n + 2 * e;
              ins16k(key, __uint_as_float((w << 16) | (unsigned)(127 - i0)));
              ins16k(key, __uint_as_float((w & 0xffff0000u) | (unsigned)(126 - i0))); }
#pragma unroll
      for (int k = 0; k < 16; ++k) { const unsigned b = __float_as_uint(key[k]); LV[lane * 16 + k] = __uint_as_float(b & 0xffffff80u); LI[lane * 16 + k] = 127 - (int)(b & 127u); } }
    LDS_WAIT(); asm volatile("" ::: "memory");
    if (lane < 32) { const int it0 = (lane >> 3) * 16 + (lane & 7) * 2;
        float s0[16], s1[16];
#pragma unroll
        for (int k = 0; k < 16; ++k) { s0[k] = LV[it0 * 16 + k]; s1[k] = LV[(it0 + 1) * 16 + k]; }
        float key[16];
#pragma unroll
        for (int k = 0; k < 16; ++k) key[k] = -3.0e38f;
#pragma unroll
        for (int a = 0; a < 16; ++a)
#pragma unroll
            for (int b = 0; b < 16; ++b) if ((a + 1) * (b + 1) <= 16) ins16k(key, __uint_as_float((__float_as_uint(s0[a] + s1[b]) & 0xffffff00u) | (unsigned)(255 - (a * 16 + b))));
        float val[16], e[16], den = 0.f; int idx[16];
#pragma unroll
        for (int k = 0; k < 16; ++k) { const unsigned b = __float_as_uint(key[k]); val[k] = __uint_as_float(b & 0xffffff00u); idx[k] = 255 - (int)(b & 255u); }
#pragma unroll
        for (int k = 0; k < 16; ++k) { e[k] = __expf(val[k] - val[0]); den += e[k]; }
        const float inv = 1.0f / den; const int ob = (slot0 + (lane >> 3)) * 128 + (lane & 7) * 16;
#pragma unroll
        for (int k = 0; k < 16; ++k) { const int i1 = LI[it0 * 16 + (idx[k] >> 4)], i2 = LI[(it0 + 1) * 16 + (idx[k] & 15)];
            EX[ob + k] = i1 * 128 + i2; GT[ob + k] = e[k] * inv; } }
    LDS_WAIT(); asm volatile("" ::: "memory");
}

#ifndef PEER_RD
#define PEER_RD 2
#endif
constexpr int PEER_NB = 8;
constexpr int PEER_RDEP = PEER_RD;
#ifdef DUP_LOAD
struct RowFrag { u32x4 a; u32x2 b; u32x4 a2; };
#elif defined(DUP_LD4)
struct RowFrag { u32x4 a; u32x2 b; unsigned a2; };
#else
struct RowFrag { u32x4 a; u32x2 b; };
#endif
DI RowFrag row_load(const GAS unsigned char* tab, int e, int lane) { const GAS unsigned char* rp = tab + (size_t)e * ROWB; RowFrag f; f.a = *(const GAS u32x4*)(rp + 16 * lane); f.b = *(const GAS u32x2*)(rp + 1024 + 8 * lane);
#ifdef DUP_LOAD
    f.a2 = *(const GAS u32x4*)(tab + (size_t)((e + 7777) & 16383) * ROWB + 16 * lane);
#elif defined(DUP_LD4)
    f.a2 = *(const GAS unsigned*)(rp + 4 * lane);
#endif
    return f; }
DI f32x32 row_unpack(const RowFrag& f) { const u32x6 w = {f.a[0], f.a[1], f.a[2], f.a[3], f.b[0], f.b[1]};
#if defined(DUP_LOAD) || defined(DUP_LD4)
    asm volatile("" :: "v"(f.a2));
#endif
#ifdef DUP_UNPACK
    { f32x32 dummy; asm volatile("v_cvt_scalef32_pk32_f32_fp6 %0, %1, 1.0" : "=v"(dummy) : "v"(w)); asm volatile("" :: "v"(dummy)); }
#endif
#ifdef DUP_FMA
    { f32x2 d0 = {0.f, 0.f}, d1 = {1.f, 1.f}; asm volatile("" : "+v"(d0), "+v"(d1));
      for (int i = 0; i < 16; ++i) asm volatile("v_pk_fma_f32 %0, %1, %1, %0" : "+v"(d0) : "v"(d1)); asm volatile("" :: "v"(d0)); }
#endif
    return __builtin_amdgcn_cvt_scalef32_pk32_f32_fp6(w, 1.0f); }

DI void time_sync(unsigned* word, unsigned target, int wave) {
    __syncthreads();
    if (wave == 0 && lane_id_opaque() == 0) { __hip_atomic_fetch_add(word, 1u, __ATOMIC_RELAXED, __HIP_MEMORY_SCOPE_AGENT); unsigned sp = 0;
        while (__hip_atomic_load(word, __ATOMIC_RELAXED, __HIP_MEMORY_SCOPE_AGENT) < target) { __builtin_amdgcn_s_sleep(1); if (++sp > (1u << 22)) break; } }
    __syncthreads();
}
template <class BarT> DI void peer_wg(Frame& F, const BarT& gbar, int tsl, int chunk64, const GAS bf16* sc, const GAS bf16* yb16, const GAS float* hrow, const GAS float* st, const GAS float* g1, const GAS float* b1, const GAS unsigned char* tabu, const GAS unsigned char* tabv, const GAS float* g2, const GAS float* b2, GAS float* xout, GAS bf16* xbout) {
    const int lane = F.lane, w = F.wave; const int tokw = chunk64 * 64 + 8 * w;
    LAS unsigned char* wl = F.lds + w * PEER_WLDS;
    LAS int* EX = (LAS int*)(wl + 8192); LAS float* GT = (LAS float*)(wl + 12288);
    LAS float* AV = (LAS float*)(wl + 1088);
    LAS float* CV = (LAS float*)(wl + 1600);
    LAS int* CN = (LAS int*)(wl + 2112);
    LAS int* BS = (LAS int*)(wl + 2368);
    peer_topk4(wl, sc, tokw, 0);
    peer_topk4(wl, sc, tokw + 4, 4);
    { const int lc = lane_id_opaque();
      *(LAS f32x4*)(wl + PEER_G1OFF + 16 * lc) = *(const GAS f32x4*)(g1 + 256 * w + 4 * lc); *(LAS f32x4*)(wl + PEER_B1OFF + 16 * lc) = *(const GAS f32x4*)(b1 + 256 * w + 4 * lc);
      *(LAS f32x4*)(wl + PEER_G2OFF + 16 * lc) = *(const GAS f32x4*)(g2 + 256 * w + 4 * lc); *(LAS f32x4*)(wl + PEER_B2OFF + 16 * lc) = *(const GAS f32x4*)(b2 + 256 * w + 4 * lc); }
    __syncthreads();
#define PEER_SO(r) ((LAS int*)(wl + ((r) & 1) * 544))
#define PEER_SORT(r) do { LAS int* so_ = PEER_SO(r); CN[lane] = 0; LDS_WAIT(); asm volatile("" ::: "memory"); int ev_[2], pos_[2]; \
        _Pragma("unroll") for (int q = 0; q < 2; ++q) { ev_[q] = EX[(r) * 128 + lane + 64 * q]; pos_[q] = __hip_atomic_fetch_add(&CN[ev_[q] >> 8], 1, __ATOMIC_RELAXED, __HIP_MEMORY_SCOPE_WAVEFRONT); } \
        LDS_WAIT(); asm volatile("" ::: "memory"); \
        { const int c = CN[lane]; int inc = c; _Pragma("unroll") for (int o = 1; o < 64; o <<= 1) { const int t_ = __shfl_up(inc, o); if (lane >= o) inc += t_; } BS[lane] = inc - c; } \
        LDS_WAIT(); asm volatile("" ::: "memory"); \
        _Pragma("unroll") for (int q = 0; q < 2; ++q) so_[BS[ev_[q] >> 8] + pos_[q]] = ev_[q] | ((lane + 64 * q) << 14); \
        if (lane < PEER_NB) so_[128 + lane] = 0; \
        LDS_WAIT(); asm volatile("" ::: "memory"); } while (0)
    RowFrag bu[PEER_RDEP];
    PEER_SORT(0);
    { LAS int* so = PEER_SO(0);
#pragma unroll
      for (int b = 0; b < PEER_RDEP; ++b) bu[b] = row_load(tabu, __builtin_amdgcn_readfirstlane(so[b]) & 16383, lane); }
#pragma unroll 1
    for (int r = 0; r < 8; ++r) {
        LAS int* SO = PEER_SO(r);
        const int t = tokw + r; const GAS float* hr = hrow + (size_t)t * D;
        const float mu1 = st[2 * t] * (1.0f / D), rs1 = 1.0f / sqrtf(st[2 * t + 1] * (1.0f / D) - mu1 * mu1 + NORM_EPS);
#define LNH(q, ln) ((__builtin_nontemporal_load((const GAS f32x4*)(hr + 256 * (q) + 4 * (ln))) - mu1) * rs1 * *(const LAS f32x4*)(F.lds + (q) * PEER_WLDS + PEER_G1OFF + 16 * (ln)) + *(const LAS f32x4*)(F.lds + (q) * PEER_WLDS + PEER_B1OFF + 16 * (ln)))
        f32x2 hv[16];
        { { float hh[32]; const int lnh = lane_id_opaque();
#pragma unroll
            for (int q = 0; q < 8; ++q) { const f32x4 a = LNH(q, lnh); hh[4 * q] = a[0]; hh[4 * q + 1] = a[1]; hh[4 * q + 2] = a[2]; hh[4 * q + 3] = a[3]; }
#pragma unroll
            for (int i = 0; i < 16; ++i) hv[i] = (f32x2){hh[fp6_map(2 * i)], hh[fp6_map(2 * i + 1)]}; }
#pragma unroll 1
          for (int base = 0; base < 128; base += PEER_NB) {
              float part[PEER_NB];
#pragma unroll
              for (int b = 0; b < PEER_NB; ++b) {
                  __builtin_amdgcn_s_setprio(2);
                  const f32x32 f = row_unpack(bu[b % PEER_RDEP]);
                  { const int nx = base + PEER_RDEP + b;
                    if (nx < 128) bu[b % PEER_RDEP] = row_load(tabu, __builtin_amdgcn_readfirstlane(SO[nx]) & 16383, lane);
                    else bu[b % PEER_RDEP] = row_load(tabv, __builtin_amdgcn_readfirstlane(SO[nx - 128]) & 16383, lane); }
                  __builtin_amdgcn_s_setprio(0);
                  f32x2 a0 = {0.f, 0.f}, a1 = {0.f, 0.f}, a2 = {0.f, 0.f}, a3 = {0.f, 0.f};
#pragma unroll
                  for (int i = 0; i < 16; i += 4) { a0 += (f32x2){f[2 * i], f[2 * i + 1]} * hv[i]; a1 += (f32x2){f[2 * i + 2], f[2 * i + 3]} * hv[i + 1];
                      a2 += (f32x2){f[2 * i + 4], f[2 * i + 5]} * hv[i + 2]; a3 += (f32x2){f[2 * i + 6], f[2 * i + 7]} * hv[i + 3]; }
                  a0 = (a0 + a1) + (a2 + a3);
                  part[b] = a0.x + a0.y;
#ifdef PEER_PIN
                  asm volatile("" ::: "memory");
#endif
              }
              const bool h5 = lane & 32, h4 = lane & 16, h3 = lane & 8; const int pidx = 4 * ((lane >> 3) & 1) + 2 * ((lane >> 4) & 1) + (lane >> 5);
#pragma unroll
              for (int g = 0; g < PEER_NB; g += 8) {
                  float r4[4], r2[2];
#pragma unroll
                  for (int i = 0; i < 4; ++i) { const float x = h5 ? part[g + 2 * i] : part[g + 2 * i + 1], y = h5 ? part[g + 2 * i + 1] : part[g + 2 * i]; r4[i] = y + __shfl_xor(x, 32); }
#pragma unroll
                  for (int i = 0; i < 2; ++i) { const float x = h4 ? r4[2 * i] : r4[2 * i + 1], y = h4 ? r4[2 * i + 1] : r4[2 * i]; r2[i] = y + __shfl_xor(x, 16); }
                  float tt; { const float x = h3 ? r2[0] : r2[1], y = h3 ? r2[1] : r2[0]; tt = y + __shfl_xor(x, 8); }
                  tt += __shfl_xor(tt, 4); tt += __shfl_xor(tt, 2); tt += __shfl_xor(tt, 1);
                  const int mm = SO[base + g + pidx];
                  if ((lane & 7) == 0) AV[mm >> 14] = tt * (1.0f / U_SCALE); } } }
        LDS_WAIT(); asm volatile("" ::: "memory");
#pragma unroll
        for (int q = 0; q < 2; ++q) { const int k = lane + 64 * q; CV[k] = GT[r * 128 + k] * gelu_erf(AV[k]) * (1.0f / V_SCALE); }
        LDS_WAIT(); asm volatile("" ::: "memory");
        if (r + 1 < 8) PEER_SORT(r + 1);
        f32x2 o[16];
#pragma unroll
        for (int k = 0; k < 16; ++k) o[k] = (f32x2){0.f, 0.f};
        { LAS int* SN = PEER_SO(r + 1);
#pragma unroll 1
          for (int base = 0; base < 128; base += PEER_NB) {
#pragma unroll
              for (int b = 0; b < PEER_NB; ++b) {
                  const float cf = CV[(SO[base + b] >> 14) & 127];
                  __builtin_amdgcn_s_setprio(2);
                  const f32x32 f = row_unpack(bu[b % PEER_RDEP]);
                  { const int nx = base + PEER_RDEP + b;
                    if (nx < 128) bu[b % PEER_RDEP] = row_load(tabv, __builtin_amdgcn_readfirstlane(SO[nx]) & 16383, lane);
                    else bu[b % PEER_RDEP] = row_load(tabu, __builtin_amdgcn_readfirstlane(SN[nx - 128]) & 16383, lane); }
                  __builtin_amdgcn_s_setprio(0);
#pragma unroll
                  for (int i = 0; i < 16; ++i) { const f32x2 v = {f[2 * i], f[2 * i + 1]}; o[i] += cf * v; }
#ifdef PEER_PIN
                  asm volatile("" ::: "memory");
#endif
              } } }
        { float y[32];
#pragma unroll
          for (int i = 0; i < 16; ++i) { y[fp6_map(2 * i)] = o[i].x + DN_ALPHA * hv[i].x; y[fp6_map(2 * i + 1)] = o[i].y + DN_ALPHA * hv[i].y; }
          float s = 0.f; const int ln2 = lane_id_opaque();
#pragma unroll
          for (int k = 0; k < 32; ++k) s += y[k];
          const float mean = wave_sum(s) * (1.0f / D); float s2 = 0.f;
#pragma unroll
          for (int k = 0; k < 32; ++k) { y[k] -= mean; s2 += y[k] * y[k]; }
          const float rstd = 1.0f / sqrtf(wave_sum(s2) * (1.0f / D) + NORM_EPS);
#pragma unroll
          for (int q = 0; q < 8; ++q) { const int c = 256 * q + 4 * ln2; const f32x4 gg = *(const LAS f32x4*)(F.lds + q * PEER_WLDS + PEER_G2OFF + 16 * ln2), bb = *(const LAS f32x4*)(F.lds + q * PEER_WLDS + PEER_B2OFF + 16 * ln2);
              const f32x4 rr = (f32x4){y[4 * q], y[4 * q + 1], y[4 * q + 2], y[4 * q + 3]} * rstd * gg + bb;
              NTST((GAS f32x4*)(xout + (size_t)t * D + c), rr);
              if (xbout) NTST((GAS u32x2*)(xbout + (size_t)t * D + c), ((u32x2){pk2(rr[0], rr[1]), pk2(rr[2], rr[3])}));
              if (q & 1) asm volatile("" ::: "memory"); } }
    }
    __syncthreads();
#undef PEER_SO
#undef PEER_SORT
}
#undef LNH
#ifndef DUPMASK
#define DUPMASK 0
#endif
#ifndef CSEL
#define CSEL 7
#endif
#ifndef PHMASK
#define PHMASK 1023
#endif
constexpr int NPH = 1 + 9 * DEPTH;
__global__ void __launch_bounds__(NWAVES * 64, 2) mega_fwd(Args args) {
    extern __shared__ __attribute__((aligned(16))) unsigned char lds_raw[];
    Frame F;
    F.lds = (LAS unsigned char*)lds_raw;
    F.wave = __builtin_amdgcn_readfirstlane(threadIdx.x >> 6); F.lane = lane_id_opaque(); F.tid = F.wave * 64 + F.lane;
#define RELANE() do { F.lane = lane_id_opaque(); F.tid = F.wave * 64 + F.lane; } while (0)
    F.G = gridDim.x; { const int bx = blockIdx.x; F.vcu = (F.G % 8 == 0) ? (bx % 8) * (F.G / 8) + bx / 8 : bx; }
    F.ws = (GAS unsigned char*)args.ws;
    unsigned* ctl = (unsigned*)(args.ws + WS_CTL);
    for (int u = threadIdx.x; u < (LDS_BYTES - LDSCTL_OFF) / 4; u += NWAVES * 64) ((LAS unsigned*)(F.lds + LDSCTL_OFF))[u] = 0u;
    __syncthreads();
    XcdBarrier bar; bar.bar = ctl + CW_BAR; bar.x = 0; bar.st = nullptr; bar.wave = F.wave;
#if !MK_PER_PHASE
    bar = xcd_barrier_post(ctl + CW_BAR, (volatile LAS unsigned*)(F.lds + MISC_OFF) + 8, F.wave);
#endif
    const int lo = args.ph_lo, hi = args.ph_hi;
#define IN(k) (lo <= (k) && (k) < hi)
#if MK_PER_PHASE
#define SEAM(k) do { } while (0)
#else
#define SEAM(k) do { if (IN(k) && IN((k) + 1)) xcd_barrier(bar); } while (0)
#endif
    const int bid = (int)blockIdx.x, G = F.G;

#ifdef BENCH
    { f32x32 bo; u32x6 bi = {1u, 2u, 3u, 4u, 5u, 6u}; u32x16 bo16; f32x2 p0 = {1.f, 2.f}, p1 = {0.5f, 0.25f}, p2 = {0.f, 0.f}; float q0 = 1.f, q1 = 0.5f, q2 = 0.f; unsigned w0 = 0x3f803f80u, w1 = 0x3f003f00u; int i0 = 0x01020304, i1 = 0x04030201, i2 = 0; unsigned ub = 0x80402010u;
      asm volatile("" : "+v"(bi), "+v"(p0), "+v"(p1), "+v"(q0), "+v"(q1), "+v"(w0), "+v"(w1), "+v"(i0), "+v"(i1), "+v"(ub));
#pragma unroll 1
      for (int it = 0; it < BENCH_N; ++it) {
#define R16(x) x x x x x x x x x x x x x x x x
#if BENCH == 1
          R16(asm volatile("v_cvt_scalef32_pk32_f32_fp6 %0, %1, 1.0" : "=v"(bo) : "v"(bi));)
#elif BENCH == 2
          R16(asm volatile("v_cvt_scalef32_pk32_bf16_fp6 %0, %1, 1.0" : "=v"(bo16) : "v"(bi));)
#elif BENCH == 3
          R16(asm volatile("v_pk_fma_f32 %0, %1, %2, %0" : "+v"(p2) : "v"(p0), "v"(p1));)
#elif BENCH == 4
          R16(asm volatile("v_fma_f32 %0, %1, %2, %0" : "+v"(q2) : "v"(q0), "v"(q1));)
#elif BENCH == 5
          R16(asm volatile("v_dot2c_f32_bf16 %0, %1, %2" : "+v"(q2) : "v"(w0), "v"(w1));)
#elif BENCH == 6
          R16(asm volatile("v_dot4_i32_i8 %0, %1, %2, %0" : "+v"(i2) : "v"(i0), "v"(i1));)
#elif BENCH == 7
          R16(asm volatile("v_cvt_f32_ubyte1 %0, %1" : "=v"(q2) : "v"(ub));)
#elif BENCH == 8
          R16(asm volatile("v_cvt_pk_f32_fp8 %0, %1" : "=v"(p2) : "v"(ub));)
#elif BENCH == 9
          { f32x2 z[16]; for (int i_ = 0; i_ < 16; ++i_) asm volatile("v_pk_fma_f32 %0, %1, %2, %1" : "=v"(z[i_]) : "v"(p0), "v"(p1)); for (int i_ = 0; i_ < 16; ++i_) asm volatile("" :: "v"(z[i_])); }
#elif BENCH == 10
          { float z[16]; for (int i_ = 0; i_ < 16; ++i_) asm volatile("v_fma_f32 %0, %1, %2, %1" : "=v"(z[i_]) : "v"(q0), "v"(q1)); for (int i_ = 0; i_ < 16; ++i_) asm volatile("" :: "v"(z[i_])); }
#endif
      }
      asm volatile("" :: "v"(bo), "v"(bo16), "v"(p2), "v"(q2), "v"(i2)); }
#endif
    if (((PHMASK >> 0) & 1) && IN(0)) for (int rep_ = 0; rep_ < ((((DUPMASK) >> 0) & 1) ? 2 : 1); ++rep_) { RELANE(); p0_prologue(F, args); }
    SEAM(0);
#pragma unroll 1
    for (int l = 0; l < DEPTH; ++l) {
        const int pb = 1 + 9 * l;
        GAS unsigned char* ws = (GAS unsigned char*)args.ws; asm volatile("" : "+s"(ws));
        GAS bf16* XB = (GAS bf16*)(ws + WS_XB); GAS float* XA = (GAS float*)(ws + WS_XA);
        GAS bf16* GATES = (GAS bf16*)(ws + WS_R1); GAS float* Y = (GAS float*)(ws + WS_R1); GAS bf16* SC = (GAS bf16*)(ws + WS_R1 + (size_t)T * D * 4);
        GAS bf16* HM = (GAS bf16*)(ws + WS_HM); GAS bf16* BR = (GAS bf16*)(ws + WS_BR); GAS bf16* PY = (GAS bf16*)(ws + WS_PY); GAS bf16* KPE = (GAS bf16*)(ws + WS_KPE); GAS float* RS = (GAS float*)(ws + WS_RS);
        GAS bf16* Q = (GAS bf16*)(ws + WS_Q); GAS bf16* KN = (GAS bf16*)(ws + WS_KN); GAS bf16* VT = (GAS bf16*)(ws + WS_VT);
        GAS bf16* MG = (GAS bf16*)(ws + WS_MG); GAS bf16* YB = (GAS bf16*)(ws + WS_HB); GAS float* ST = (GAS float*)(ws + WS_ST);
        const GAS float* CSl = (const GAS float*)(ws + WS_CTL) + CW_CS + l * 2048; const GAS float* BWl = (const GAS float*)(ws + WS_CTL) + CW_BW + l * 2048;
        const GAS float* cosb = (const GAS float*)(ws + WS_ROPE); const GAS float* sinb = cosb + SEQ * 32;
        if (((PHMASK >> 1) & 1) && IN(pb + 0)) for (int rep_ = 0; rep_ < ((((DUPMASK) >> 1) & 1) ? 2 : 1); ++rep_) {
            pg8::Gemm g{XB, (const GAS bf16*)(ws + WS_WIN + l * SZ_WIN), D, D, D}; pg8::StaticOrder S; S.init(T, N1, G, bid);
            pg8::EpiGemm1 E{GATES, HM};
            pg8::gemm_phase(F.lds, F.wave, g, S, E);
        }
        SEAM(pb + 0);
        if (((PHMASK >> 2) & 1) && IN(pb + 1)) for (int rep_ = 0; rep_ < ((((DUPMASK) >> 2) & 1) ? 2 : 1); ++rep_) {
            RELANE();
            for (int u = F.vcu; u < 256; u += G) swa_unit(F, u, HM, BR, ((const GAS float*)args.in[3]) + l * 8);
            for (int ch = F.vcu; ch < 256; ch += G) elem_chunk(F, ch, HM, BR, PY, KPE, RS, ST, ((const GAS float*)args.in[2]) + l * 3 * 512, cosb, sinb);
        }
        SEAM(pb + 1);
        if (((PHMASK >> 3) & 1) && IN(pb + 2)) for (int rep_ = 0; rep_ < ((((DUPMASK) >> 3) & 1) ? 2 : 1); ++rep_) {
            if (CSEL & 1) { pg8::Gemm g{HM + C_CQ, (const GAS bf16*)(ws + WS_WQUP + l * SZ_WQUP), 512, HM_LD, 512}; pg8::StaticOrder S; S.init(T, 768, G, bid);
              pg8::EpiQ E{Q, RS, cosb, sinb}; pg8::gemm_phase(F.lds, F.wave, g, S, E); }
            if (CSEL & 2) { pg8::Gemm g{HM + C_CKV, (const GAS bf16*)(ws + WS_WKVUP + l * SZ_WKVUP), 256, HM_LD, 256}; pg8::StaticOrder S; S.init(T, 1024, G, bid);
              pg8::EpiKV E{KN, VT, RS}; pg8::gemm_phase(F.lds, F.wave, g, S, E); }
            if (CSEL & 4) { pg8::Gemm g{PY, (const GAS bf16*)(ws + WS_WPOOL + l * SZ_WPOOL), 512, 512, 512}; pg8::StaticOrder S; S.init(T, 512, G, (bid + 64) % G);
              pg8::EpiPool E{BR, ((const GAS float*)args.in[9]) + l * 512}; pg8::gemm_phase(F.lds, F.wave, g, S, E); }
        }
        SEAM(pb + 2);
        if (((PHMASK >> 4) & 1) && IN(pb + 3)) for (int rep_ = 0; rep_ < ((((DUPMASK) >> 4) & 1) ? 2 : 1); ++rep_) { RELANE(); mla_phase(F, Q, KN, KPE, VT, BR); }
        SEAM(pb + 3);
        if (((PHMASK >> 5) & 1) && IN(pb + 4)) for (int rep_ = 0; rep_ < ((((DUPMASK) >> 5) & 1) ? 2 : 1); ++rep_) {
            pg8::Gemm g{BR, (const GAS bf16*)(ws + WS_WBR + l * SZ_WBR), 512, D, 512}; pg8::MergeOrder S{G, bid};
            pg8::EpiMerge E{GATES, MG};
            pg8::gemm_phase(F.lds, F.wave, g, S, E);
        }
        SEAM(pb + 4);
        if (((PHMASK >> 6) & 1) && IN(pb + 5)) for (int rep_ = 0; rep_ < ((((DUPMASK) >> 6) & 1) ? 2 : 1); ++rep_) {
            pg8::Gemm g{MG, (const GAS bf16*)(ws + WS_WOUT + l * SZ_WSQ), D, D, D}; pg8::StaticOrder S; S.init(T, D, G, bid);
            pg8::EpiOut E{l == 0 ? ((const GAS float*)args.in[0]) : XA, Y, YB, ST};
            pg8::gemm_phase(F.lds, F.wave, g, S, E);
        }
        SEAM(pb + 5);
        if (((PHMASK >> 8) & 1) && IN(pb + 7)) for (int rep_ = 0; rep_ < ((((DUPMASK) >> 8) & 1) ? 2 : 1); ++rep_) {
            pg8::Gemm g{YB, (const GAS bf16*)(ws + WS_WPQ + l * SZ_WSQ), D, D, D}; pg8::StaticOrder S; S.init(T, D, G, bid);
            pg8::EpiScore E{SC, ST, CSl, BWl};
            pg8::gemm_phase(F.lds, F.wave, g, S, E);
        }
        SEAM(pb + 7);
        if (((PHMASK >> 9) & 1) && IN(pb + 8)) for (int rep_ = 0; rep_ < ((((DUPMASK) >> 9) & 1) ? 2 : 1); ++rep_) {
            RELANE(); const bool lastl = (l == DEPTH - 1);
#ifdef DBG_HALFPEER
            if ((((int)blockIdx.x >> 3) & 1) == 0)
            for (int ch = ((int)blockIdx.x & 7) * 16 + ((int)blockIdx.x >> 4); ch < T / 64; ch += G / 2)
#else
            for (int ch = F.vcu; ch < T / 64; ch += G)
#endif
                peer_wg(F, bar, l, ch, SC, YB, Y, ST, ((const GAS float*)args.in[12]) + l * D, ((const GAS float*)args.in[13]) + l * D, (const GAS unsigned char*)(ws + WS_TABU + l * SZ_TAB), (const GAS unsigned char*)(ws + WS_TABV + l * SZ_TAB), ((const GAS float*)args.in[18]) + l * D, ((const GAS float*)args.in[19]) + l * D,
                           lastl ? (GAS float*)args.out : XA, lastl ? (GAS bf16*)nullptr : XB);
        }
        if (l + 1 < DEPTH) SEAM(pb + 8);
    }
#undef IN
#undef SEAM
}

extern "C" void kernel_launch(void* const* d_in, const int* in_sizes, int n_in, void* d_out, int out_size, void* d_ws, size_t ws_size, hipStream_t stream) {
    static int grid = 0;
    if (grid == 0) {
        if (n_in != 20 || out_size != T * D || ws_size < WS_END) { fprintf(stderr, "kernel_launch: unexpected shapes (n_in %d, out %d, ws %zu need %zu)\n", n_in, out_size, ws_size, (size_t)WS_END); grid = -1; return; }
        int dev = 0, cus = 0, per_cu = 0;
        if (hipGetDevice(&dev) != hipSuccess || hipDeviceGetAttribute(&cus, hipDeviceAttributeMultiprocessorCount, dev) != hipSuccess) { grid = -1; return; }
        if (hipFuncSetAttribute((const void*)mega_fwd, hipFuncAttributeMaxDynamicSharedMemorySize, LDS_BYTES) != hipSuccess) { fprintf(stderr, "kernel_launch: hipFuncSetAttribute failed\n"); grid = -1; return; }
        if (hipOccupancyMaxActiveBlocksPerMultiprocessor(&per_cu, (const void*)mega_fwd, NWAVES * 64, LDS_BYTES) != hipSuccess || per_cu < 1) { fprintf(stderr, "kernel_launch: occupancy query says %d\n", per_cu); }
        (void)hipGetLastError();
        grid = cus;
    }
    if (grid < 0) return;
    if (hipMemsetAsync((char*)d_ws + WS_CTL, 0, CTL_ZERO_BYTES, stream) != hipSuccess) return;
    Args a{};
    for (int i = 0; i < 20; ++i) a.in[i] = (const float*)d_in[i];
    a.out = (float*)d_out; a.ws = (unsigned char*)d_ws;
#if MK_PER_PHASE
    for (int p = 0; p < NPH; ++p) { a.ph_lo = p; a.ph_hi = p + 1; hipLaunchKernelGGL(mega_fwd, dim3(grid), dim3(NWAVES * 64), LDS_BYTES, stream, a); }
#else
    a.ph_lo = 0; a.ph_hi = NPH;
    hipLaunchKernelGGL(mega_fwd, dim3(grid), dim3(NWAVES * 64), LDS_BYTES, stream, a);
#endif
}
```
